# Optimizing an MI355X kernel written in HIP

```python
import numpy as np
import jax, jax.numpy as jnp
from jax import lax

D_MODEL = 1024
BATCH = 4
SEQ = 4096
DEPTH = 2

GRID_W = 64
WIN_R = 8
WIN_C = 16
NA_HEADS = 8
NA_HEAD_DIM = D_MODEL // 16
NA_WIDTH = NA_HEADS * NA_HEAD_DIM
GLA_HEADS = 4
GLA_DK = D_MODEL // 16
GLA_DV = D_MODEL // 8
GLA_KEY_WIDTH = GLA_HEADS * GLA_DK
GLA_VAL_WIDTH = GLA_HEADS * GLA_DV
GLA_RANK = 16
GLA_TAU = 16.0
HGRN_HEADS = 4
HGRN_DK = 128
HGRN_DV = D_MODEL // 8
HGRN_KEY_WIDTH = HGRN_HEADS * HGRN_DK
HGRN_VAL_WIDTH = HGRN_HEADS * HGRN_DV
CHUNK = 16
N_BRANCHES = 3
PROJ_SIZES = (NA_WIDTH, NA_WIDTH, NA_WIDTH,
              GLA_KEY_WIDTH, GLA_KEY_WIDTH, GLA_VAL_WIDTH, GLA_VAL_WIDTH, 2 * GLA_RANK,
              HGRN_KEY_WIDTH, 2 * HGRN_KEY_WIDTH, HGRN_VAL_WIDTH, HGRN_VAL_WIDTH,
              N_BRANCHES * D_MODEL)
PROJ_WIDTH = sum(PROJ_SIZES)
FFN_HIDDEN = ((8 * D_MODEL // 3 + 255) // 256) * 256
N_MOD = 6
RMS_EPS = 1e-6
NEG_INF = -1e30
F_FLOOR = 1e-30

kernel_name = 'hybrid_na_gla_hgrn2_encoder'


def rmsnorm(x, w):
    xf = x.astype(jnp.float32)
    y = xf * lax.rsqrt(jnp.mean(xf * xf, axis=-1, keepdims=True) + RMS_EPS)
    return (y * w.astype(jnp.float32)).astype(x.dtype)


def to_heads(a, n):
    b, t, _ = a.shape
    return a.reshape(b, t, n, -1).transpose(0, 2, 1, 3)


def from_heads(a):
    b, h, t, d = a.shape
    return a.transpose(0, 2, 1, 3).reshape(b, t, h * d)


def neighborhood_attention(q, k, v, rpb):
    bsz, t, _ = q.shape
    rows = t // GRID_W
    wr = min(WIN_R, rows)
    def grid(a):
        return a.reshape(bsz, rows, GRID_W, NA_HEADS, NA_HEAD_DIM).transpose(0, 3, 1, 2, 4)
    qg = grid(q) * (NA_HEAD_DIM ** -0.5)
    kg, vg = grid(k), grid(v)
    r = jnp.arange(rows)
    row_start = jnp.clip(r - WIN_R // 2, 0, rows - wr)
    row_idx = row_start[:, None] + jnp.arange(wr)[None, :]
    k_band = kg[:, :, row_idx]
    v_band = vg[:, :, row_idx]
    col = jnp.arange(GRID_W)
    col_start = jnp.clip(col - WIN_C // 2, 0, GRID_W - WIN_C)
    col_mask = (col[None, :] >= col_start[:, None]) & (col[None, :] < col_start[:, None] + WIN_C)
    row_off = row_idx - r[:, None] + (WIN_R - 1)
    col_off = jnp.clip(col[None, :] - col[:, None], -(WIN_C - 1), WIN_C - 1) + (WIN_C - 1)
    bias = rpb[:, row_off[:, None, :, None], col_off[None, :, None, :]]
    s = jnp.einsum('bhrqd,bhrjkd->bhrqjk', qg, k_band).astype(jnp.float32) + bias.astype(jnp.float32)
    s = jnp.where(col_mask[:, None, :], s, NEG_INF)
    p = jax.nn.softmax(s.reshape(bsz, NA_HEADS, rows, GRID_W, wr * GRID_W), axis=-1)
    p = p.reshape(s.shape).astype(v.dtype)
    o = jnp.einsum('bhrqjk,bhrjkd->bhrqd', p, v_band)
    return o.transpose(0, 2, 3, 1, 4).reshape(bsz, t, NA_WIDTH)


def chunk_gated_linear_attention(q, k, v, log_a):
    bsz, nh, t, dk = q.shape
    dv = v.shape[-1]
    n = t // CHUNK
    q, k, v, log_a = [a.astype(jnp.float32).reshape(bsz, nh, n, CHUNK, a.shape[-1]) for a in (q, k, v, log_a)]
    b = jnp.cumsum(log_a, axis=3)
    tri = jnp.tril(jnp.ones((CHUNK, CHUNK), dtype=bool))[:, :, None]
    diff = b[:, :, :, :, None, :] - b[:, :, :, None, :, :]
    decay = jnp.where(tri, jnp.exp(jnp.where(tri, diff, 0.0)), 0.0)
    scores = jnp.einsum('bhnid,bhnjd,bhnijd->bhnij', q, k, decay)
    o_intra = jnp.einsum('bhnij,bhnjv->bhniv', scores, v)
    b_last = b[:, :, :, -1:, :]
    q_dec = q * jnp.exp(b)
    k_dec = k * jnp.exp(b_last - b)
    a_chunk = jnp.exp(b_last[:, :, :, 0, :])
    def step(state, xs):
        qn, kn, vn, an = xs
        o = jnp.einsum('bhid,bhdv->bhiv', qn, state)
        state = an[..., None] * state + jnp.einsum('bhjd,bhjv->bhdv', kn, vn)
        return state, o
    xs = tuple(jnp.moveaxis(a, 2, 0) for a in (q_dec, k_dec, v, a_chunk))
    _, o_inter = lax.scan(step, jnp.zeros((bsz, nh, dk, dv), jnp.float32), xs)
    o = o_intra + jnp.moveaxis(o_inter, 0, 2)
    return o.reshape(bsz, nh, t, dv)


def bidirectional_gla(q, k_fwd, k_bwd, v, la_fwd, la_bwd):
    flip = lambda a: jnp.flip(a, axis=2)
    fwd = chunk_gated_linear_attention(q, k_fwd, v, la_fwd)
    bwd = chunk_gated_linear_attention(flip(q), flip(k_bwd), flip(v), flip(la_bwd))
    return fwd + flip(bwd)


def gla_branch(q, k, v, g, lr, lr_up, lr_bias, norm_w):
    bsz, t, _ = q.shape
    z = jnp.einsum('btsr,srk->btsk', lr.reshape(bsz, t, 2, GLA_RANK), lr_up) + lr_bias
    log_a = jax.nn.log_sigmoid(z.astype(jnp.float32)) / GLA_TAU
    la_f = to_heads(log_a[:, :, 0], GLA_HEADS)
    la_b = to_heads(log_a[:, :, 1], GLA_HEADS)
    qh = to_heads(q, GLA_HEADS) * (GLA_DK ** -0.5)
    kh = to_heads(k, GLA_HEADS)
    vh = to_heads(v, GLA_HEADS)
    o = bidirectional_gla(qh, kh, kh, vh, la_f, la_b)
    o = rmsnorm(o, norm_w) * jax.nn.silu(to_heads(g, GLA_HEADS).astype(jnp.float32))
    return from_heads(o).astype(q.dtype)


def hgrn2_branch(q, f, i, g, lb, norm_w):
    bsz, t, _ = q.shape
    z = f.reshape(bsz, t, 2, HGRN_KEY_WIDTH).astype(jnp.float32)
    lbf = lb.astype(jnp.float32)
    forget = lbf + (1.0 - lbf) * jax.nn.sigmoid(z)
    log_f = jnp.log(jnp.maximum(forget, F_FLOOR))
    k_in = (1.0 - lbf) * jax.nn.sigmoid(-z)
    qh = to_heads(jax.nn.silu(q), HGRN_HEADS)
    vh = to_heads(i, HGRN_HEADS)
    o = bidirectional_gla(qh,
                          to_heads(k_in[:, :, 0], HGRN_HEADS), to_heads(k_in[:, :, 1], HGRN_HEADS), vh,
                          to_heads(log_f[:, :, 0], HGRN_HEADS), to_heads(log_f[:, :, 1], HGRN_HEADS))
    o = rmsnorm(o, norm_w) * jax.nn.silu(to_heads(g, HGRN_HEADS).astype(jnp.float32))
    return from_heads(o).astype(q.dtype)


def setup_inputs(seed: int = 0) -> dict:
    key = jax.random.key(seed)
    ks = jax.random.split(key, 24)
    nrm = lambda k, shape, scale: jax.random.normal(k, shape, jnp.float32) * scale
    return {
        'x': nrm(ks[0], (BATCH, SEQ, D_MODEL), 1.0),
        'c': nrm(ks[1], (BATCH, D_MODEL), 1.0),
        'w_ada': nrm(ks[2], (DEPTH, D_MODEL, N_MOD * D_MODEL), D_MODEL ** -0.5),
        'b_ada': nrm(ks[3], (DEPTH, N_MOD * D_MODEL), 0.02),
        'norm1_w': 1.0 + nrm(ks[4], (DEPTH, D_MODEL), 0.02),
        'w_in': nrm(ks[5], (DEPTH, D_MODEL, PROJ_WIDTH), D_MODEL ** -0.5),
        'na_rpb': nrm(ks[6], (DEPTH, NA_HEADS, 2 * WIN_R - 1, 2 * WIN_C - 1), 0.1),
        'gla_lr_up': nrm(ks[7], (DEPTH, 2, GLA_RANK, GLA_KEY_WIDTH), GLA_RANK ** -0.5),
        'gla_lr_bias': nrm(ks[8], (DEPTH, 2, GLA_KEY_WIDTH), 0.02),
        'gla_norm_w': 1.0 + nrm(ks[9], (DEPTH, GLA_DV), 0.02),
        'hgrn_lb_logits': nrm(ks[10], (DEPTH, 2 * HGRN_KEY_WIDTH), 1.0),
        'hgrn_norm_w': 1.0 + nrm(ks[11], (DEPTH, HGRN_DV), 0.02),
        'w_proj_na': nrm(ks[12], (DEPTH, NA_WIDTH, D_MODEL), NA_WIDTH ** -0.5),
        'w_proj_gla': nrm(ks[13], (DEPTH, GLA_VAL_WIDTH, D_MODEL), GLA_VAL_WIDTH ** -0.5),
        'w_proj_hgrn': nrm(ks[14], (DEPTH, HGRN_VAL_WIDTH, D_MODEL), HGRN_VAL_WIDTH ** -0.5),
        'w_out': nrm(ks[15], (DEPTH, D_MODEL, D_MODEL), D_MODEL ** -0.5),
        'norm2_w': 1.0 + nrm(ks[16], (DEPTH, D_MODEL), 0.02),
        'w_ffn_gate': nrm(ks[17], (DEPTH, D_MODEL, FFN_HIDDEN), D_MODEL ** -0.5),
        'w_ffn_up': nrm(ks[18], (DEPTH, D_MODEL, FFN_HIDDEN), D_MODEL ** -0.5),
        'w_ffn_down': nrm(ks[19], (DEPTH, FFN_HIDDEN, D_MODEL), FFN_HIDDEN ** -0.5),
        'final_norm_w': 1.0 + nrm(ks[20], (D_MODEL,), 0.02),
    }


def reference(x, c, w_ada, b_ada, norm1_w, w_in, na_rpb, gla_lr_up, gla_lr_bias, gla_norm_w,
              hgrn_lb_logits, hgrn_norm_w, w_proj_na, w_proj_gla, w_proj_hgrn, w_out, norm2_w,
              w_ffn_gate, w_ffn_up, w_ffn_down, final_norm_w):
    split_points = [int(s) for s in np.cumsum(PROJ_SIZES)[:-1]]
    lb_p = jax.nn.softmax(hgrn_lb_logits.astype(jnp.float32), axis=0)
    lb_all = jnp.clip(jnp.cumsum(lb_p, axis=0) - lb_p[0], 0.0, 1.0)
    c_act = jax.nn.silu(c)
    for l in range(DEPTH):
        mod = c_act @ w_ada[l] + b_ada[l]
        shift1, scale1, gate1, shift2, scale2, gate2 = jnp.split(mod[:, None, :], N_MOD, axis=-1)
        h = rmsnorm(x, norm1_w[l]) * (1.0 + scale1) + shift1
        p = h @ w_in[l]
        (na_q, na_k, na_v, gla_q, gla_k, gla_v, gla_g, gla_lr,
         hg_q, hg_f, hg_i, hg_g, gates) = jnp.split(p, split_points, axis=-1)
        o_na = neighborhood_attention(na_q, na_k, na_v, na_rpb[l])
        o_gla = gla_branch(gla_q, gla_k, gla_v, gla_g, gla_lr, gla_lr_up[l], gla_lr_bias[l], gla_norm_w[l])
        o_hg = hgrn2_branch(hg_q, hg_f, hg_i, hg_g, lb_all[l].reshape(2, HGRN_KEY_WIDTH), hgrn_norm_w[l])
        g_na, g_gla, g_hg = jnp.split(jax.nn.sigmoid(gates), N_BRANCHES, axis=-1)
        merged = (g_na * (o_na @ w_proj_na[l]) + g_gla * (o_gla @ w_proj_gla[l])
                  + g_hg * (o_hg @ w_proj_hgrn[l]))
        x = x + gate1 * (merged @ w_out[l])
        h = rmsnorm(x, norm2_w[l]) * (1.0 + scale2) + shift2
        ff = (jax.nn.silu(h @ w_ffn_gate[l]) * (h @ w_ffn_up[l])) @ w_ffn_down[l]
        x = x + gate2 * ff
    return rmsnorm(x, final_norm_w)
```

```cpp
#include <hip/hip_runtime.h>
#include <hip/hip_cooperative_groups.h>
#include <cstdio>
namespace cg = cooperative_groups;

#define LAS __attribute__((address_space(3)))
typedef unsigned short bf16_t;
typedef short bf16x8 __attribute__((ext_vector_type(8)));
typedef float f32x4 __attribute__((ext_vector_type(4)));
typedef unsigned u32x4 __attribute__((ext_vector_type(4)));
typedef unsigned u32x2 __attribute__((ext_vector_type(2)));

constexpr int D = 1024, T = 4096, NBATCH = 4, M = NBATCH * T, MH = M / 2, DEPTH = 2;
constexpr int PROJW = 8736, LDP = 5664, NPAD = 8960, FF = 2816;
constexpr int C_NAQ = 0, C_NAK = 512, C_NAV = 1024, C_GQ = 1536, C_GK = 1792, C_GV = 2048, C_GG = 2560, C_HQ = 3072, C_HF = 3584, C_HI = 4608, C_HG = 5120, C_LR = 5632;
constexpr int LDS_BYTES = 135168 + 2048;

constexpr size_t WS_CTL = 0;
constexpr size_t WS_BAR = 1024;
constexpr size_t WS_MOD = 32768;
constexpr size_t WS_LB = WS_MOD + 2 * 4 * 6144 * 4;
constexpr size_t WS_WIN = WS_LB + 2 * 1024 * 4;
constexpr size_t WS_WPROJ = WS_WIN + (size_t)NPAD * 1024 * 2;
constexpr size_t WS_WOUT = WS_WPROJ + (size_t)3 * 1024 * 512 * 2;
constexpr size_t WS_WGU = WS_WOUT + (size_t)1024 * 1024 * 2;
constexpr size_t WS_WDN = WS_WGU + (size_t)5632 * 1024 * 2;
constexpr size_t WS_H = WS_WDN + (size_t)1024 * 2816 * 2;
constexpr size_t WS_MERGED = WS_H + (size_t)MH * 1024 * 2;
constexpr size_t WS_OACC = WS_MERGED + (size_t)MH * 1024 * 2;
constexpr size_t WS_P = WS_OACC + (size_t)MH * 1024 * 4;
constexpr size_t WS_GT = WS_P + (size_t)MH * LDP * 2;
constexpr size_t WS_H2 = WS_P;
constexpr size_t WS_HID = WS_P + (size_t)M * 1024 * 2;
constexpr size_t WS_END = WS_GT + (size_t)MH * 3072 * 2;
static_assert(WS_HID + (size_t)M * FF * 2 <= WS_END, "ffn scratch must fit in the P region");
constexpr size_t WS_SLOC = WS_END;
constexpr size_t WS_LA = WS_SLOC + (size_t)1536 * 8192;
constexpr size_t WS_END2 = WS_LA + (size_t)1536 * 512;
static_assert(WS_END2 <= (size_t)256 * 1024 * 1024, "workspace must fit the guaranteed 256 MiB");

struct Params {
    const float* in[21];
    float* out;
    unsigned char* ws;
};

__device__ __forceinline__ float bf2f(unsigned short b) { return __uint_as_float(((unsigned)b) << 16); }
__device__ __forceinline__ float bflo(unsigned w) { return __uint_as_float(w << 16); }
__device__ __forceinline__ float bfhi(unsigned w) { return __uint_as_float(w & 0xffff0000u); }
typedef float f32x2_t __attribute__((ext_vector_type(2)));
typedef __bf16 bf16x2_t __attribute__((ext_vector_type(2)));
__device__ __forceinline__ unsigned cvt_pk_bf16(float lo, float hi) { f32x2_t f = {lo, hi}; bf16x2_t v = __builtin_convertvector(f, bf16x2_t); return __builtin_bit_cast(unsigned, v); }
__device__ __forceinline__ float sigmoidf_(float x) { return __builtin_amdgcn_rcpf(1.f + __expf(-x)); }
__device__ __forceinline__ float siluf_(float x) { return x * __builtin_amdgcn_rcpf(1.f + __expf(-x)); }
__device__ __forceinline__ int otid() { int t = threadIdx.x; asm volatile("" : "+v"(t)); return t; }
__device__ __forceinline__ float wave_sum(float v) {
#pragma unroll
    for (int o = 1; o < 64; o <<= 1) v += __shfl_xor(v, o);
    return v;
}

namespace pg8 {
constexpr int BM = 256, BK = 64, HALF = 128, HTB = HALF * BK * 2, STAGE_BYTES = 8 * HTB, NXCD = 8, WGM = 8;
__device__ __forceinline__ int lds_byte(int r, int c) { const int st = (r >> 4) * 2 + (c >> 5), rr = r & 15, cc = c & 31, ob = rr * 64 + cc * 2; return st * 1024 + (ob ^ (((ob >> 9) & 1) << 5)); }
__device__ __forceinline__ void stage_rc(int b, int& R, int& C) { const int st = b / 1024, sb = b % 1024, swz = sb ^ (((sb >> 9) & 1) << 5); R = (st >> 1) * 16 + swz / 64; C = (st & 1) * 32 + (swz % 64) / 2; }
__device__ __forceinline__ int perm32(int rho) { const int n = rho >> 4, i = rho & 15; return 8 * (i >> 2) + 4 * n + (i & 3); }
struct Unit { int pm, pn, b; };
struct Gemm { const bf16_t* A; int lda; const bf16_t* Bt; int M, N, K; size_t astep, bstep; };
struct StaticOrder {
    int nM, nN, nwg, G, c;
    __device__ void init(int M_, int N_, int G_, int c_) { nM = M_ / BM; nN = N_ / BM; nwg = nM * nN; G = G_; c = c_; }
    __device__ bool next(int i, Unit& u) const {
        const long L = (long)i * G + c; if (L >= nwg) return false;
        int wgid = (int)L; { const int q = nwg / NXCD, r = nwg % NXCD, xcd = wgid % NXCD, off = wgid / NXCD; wgid = (xcd < r ? xcd * (q + 1) : r * (q + 1) + (xcd - r) * q) + off; }
        const int nig = WGM * nN, gid = wgid / nig, fm = gid * WGM, gsz = (nM - fm) < WGM ? (nM - fm) : WGM;
        u.pm = fm + ((wgid % nig) % gsz); u.pn = (wgid % nig) / gsz; u.b = 0; return true;
    }
};
struct SplitOrder : StaticOrder {
    int side, half_g;
    __device__ void init2(int M_, int N_, int G_, int c_) { half_g = G_ / 2; side = c_ >= half_g ? 1 : 0; init(M_, N_, half_g, c_ - side * half_g); }
    __device__ bool next(int i, Unit& u) const {
        const int nb = side ? 1 : 2, q = i / nb; if (!StaticOrder::next(q, u)) return false; u.b = side ? 2 : (i - q * nb); return true; }
};

template <class Epi, class Sched>
__device__ __forceinline__ void gemm_phase(LAS unsigned char* lds, const Gemm g, const Sched& S, const Epi& E) {
    const int tid = otid(), wid = __builtin_amdgcn_readfirstlane(tid >> 6), lane = tid & 63, wr = wid >> 2, wc = wid & 3, fr = lane & 15, fq = lane >> 4;
    const int K = g.K, nt = K / BK, lda = g.lda;
    unsigned voffA[2], voffB[2];
#pragma unroll
    for (int i = 0; i < 2; ++i) { int R, C; stage_rc(tid * 16 + i * 8192, R, C); const int Rb = Epi::PERM ? ((R & ~31) + perm32(R & 31)) : R;
        voffA[i] = (unsigned)(R * lda + C) * 2u; voffB[i] = (unsigned)(Rb * K + C) * 2u; }
    const size_t kstep = (size_t)(BK * 2);
    const size_t hstepA = (size_t)HALF * lda * 2, hstepB = (size_t)HALF * K * 2;
    const size_t tstepA = 2 * hstepA, tstepB = 2 * hstepB;
    const unsigned ldsw = (unsigned)wid * 1024u;
    const int aoff = lds_byte(wr * 64 + fr, fq * 8), boff = lds_byte(wc * 32 + fr, fq * 8);
#define PG8_SA(b, h) (((b) * 2 + (h)) * HTB)
#define PG8_SB(b, h) ((4 + (b) * 2 + (h)) * HTB)
#define PG8_STAGE(bufoff, gbase, voff) do { _Pragma("unroll") for (int _i = 0; _i < 2; ++_i) \
        __builtin_amdgcn_global_load_lds((const unsigned*)((const char*)(gbase) + (voff)[_i]), (LAS unsigned*)(lds + (bufoff) + ldsw + _i * 8192), 16, 0, 0); } while (0)
#define PG8_LDA(dst, b, h) do { _Pragma("unroll") for (int m = 0; m < 4; ++m) _Pragma("unroll") for (int k = 0; k < 2; ++k) dst[m][k] = *(const LAS bf16x8*)(lds + PG8_SA(b, h) + aoff + m * 2048 + k * 1024); } while (0)
#define PG8_LDB(dst, b, h) do { _Pragma("unroll") for (int n = 0; n < 2; ++n) _Pragma("unroll") for (int k = 0; k < 2; ++k) dst[n][k] = *(const LAS bf16x8*)(lds + PG8_SB(b, h) + boff + n * 2048 + k * 1024); } while (0)
#define PG8_MMA(ai, bj, At, Bt) do { __builtin_amdgcn_s_setprio(1); _Pragma("unroll") for (int m = 0; m < 4; ++m) _Pragma("unroll") for (int n = 0; n < 2; ++n) _Pragma("unroll") for (int k = 0; k < 2; ++k) \
        acc[ai][bj][m][n] = __builtin_amdgcn_mfma_f32_16x16x32_bf16(Bt[n][k], At[m][k], acc[ai][bj][m][n], 0, 0, 0); __builtin_amdgcn_s_setprio(0); } while (0)
#define PG8_WAIT_V(n) asm volatile("s_waitcnt vmcnt(" #n ")" ::: "memory")
#define PG8_WAIT_L(n) asm volatile("s_waitcnt lgkmcnt(" #n ")" ::: "memory")
#define PG8_BAR __builtin_amdgcn_s_barrier()
#define PG8_SCHED __builtin_amdgcn_sched_barrier(0)
    Unit cur, nxt; int ui = 0;
    if (!S.next(0, cur)) return;
    f32x4 acc[2][2][4][2];
#pragma unroll
    for (int a = 0; a < 2; ++a)
#pragma unroll
        for (int b = 0; b < 2; ++b)
#pragma unroll
            for (int m = 0; m < 4; ++m)
#pragma unroll
                for (int n = 0; n < 2; ++n) acc[a][b][m][n] = (f32x4){0.f, 0.f, 0.f, 0.f};
    bf16x8 At[4][2], B0[2][2], B1[2][2];
    const char* cA = (const char*)g.A + (size_t)cur.pm * tstepA + cur.b * g.astep; const char* cB = (const char*)g.Bt + (size_t)cur.pn * tstepB + cur.b * g.bstep;
    PG8_STAGE(PG8_SB(0, 0), cB, voffB); PG8_STAGE(PG8_SA(0, 0), cA, voffA); PG8_STAGE(PG8_SB(0, 1), cB + hstepB, voffB); PG8_STAGE(PG8_SA(0, 1), cA + hstepA, voffA);
    if (wr == 1) PG8_BAR;
    PG8_WAIT_V(4); PG8_BAR;
    PG8_STAGE(PG8_SB(1, 0), cB + kstep, voffB); PG8_STAGE(PG8_SA(1, 0), cA + kstep, voffA); PG8_STAGE(PG8_SB(1, 1), cB + hstepB + kstep, voffB);
    PG8_WAIT_V(6); PG8_BAR;
    for (;;) {
        const bool has_next = S.next(ui + 1, nxt);
        const char* nA = has_next ? (const char*)g.A + (size_t)nxt.pm * tstepA + nxt.b * g.astep : cA; const char* nB = has_next ? (const char*)g.Bt + (size_t)nxt.pn * tstepB + nxt.b * g.bstep : cB;
        for (int t = 0; t < nt; t += 2) {
            const bool last = (t == nt - 2);
            const char* a1 = cA + (size_t)(t + 1) * kstep;
            const char* a2 = last ? nA : cA + (size_t)(t + 2) * kstep; const char* b2 = last ? nB : cB + (size_t)(t + 2) * kstep;
            const char* a3 = a2 + kstep; const char* b3 = b2 + kstep;
            PG8_LDB(B0, 0, 0); PG8_SCHED; PG8_LDA(At, 0, 0); PG8_STAGE(PG8_SA(1, 1), a1 + hstepA, voffA);
            PG8_WAIT_L(8); PG8_BAR; PG8_WAIT_L(0); PG8_MMA(0, 0, At, B0); PG8_BAR; PG8_SCHED;
            PG8_LDB(B1, 0, 1); PG8_STAGE(PG8_SB(0, 0), b2, voffB);
            PG8_BAR; PG8_WAIT_L(0); PG8_MMA(0, 1, At, B1); PG8_BAR;
            PG8_LDA(At, 0, 1); PG8_STAGE(PG8_SA(0, 0), a2, voffA);
            PG8_BAR; PG8_WAIT_L(0); PG8_MMA(1, 0, At, B0); PG8_BAR; PG8_SCHED;
            PG8_STAGE(PG8_SB(0, 1), b2 + hstepB, voffB);
            PG8_WAIT_V(6); PG8_BAR; PG8_MMA(1, 1, At, B1); PG8_BAR;
            PG8_LDB(B0, 1, 0); PG8_SCHED; PG8_LDA(At, 1, 0); PG8_STAGE(PG8_SA(0, 1), a2 + hstepA, voffA);
            PG8_WAIT_L(8); PG8_BAR; PG8_WAIT_L(0); PG8_MMA(0, 0, At, B0); PG8_BAR; PG8_SCHED;
            PG8_LDB(B1, 1, 1); PG8_STAGE(PG8_SB(1, 0), b3, voffB);
            PG8_BAR; PG8_WAIT_L(0); PG8_MMA(0, 1, At, B1); PG8_BAR;
            PG8_LDA(At, 1, 1); PG8_STAGE(PG8_SA(1, 0), a3, voffA);
            PG8_BAR; PG8_WAIT_L(0); PG8_MMA(1, 0, At, B0); PG8_BAR; PG8_SCHED;
            PG8_STAGE(PG8_SB(1, 1), b3 + hstepB, voffB);
            PG8_WAIT_V(6); PG8_BAR; PG8_MMA(1, 1, At, B1); PG8_BAR;
        }
        E(acc, cur, wr, wc, fr, fq);
        if (!has_next) break;
#pragma unroll
        for (int a = 0; a < 2; ++a)
#pragma unroll
            for (int b = 0; b < 2; ++b)
#pragma unroll
                for (int m = 0; m < 4; ++m)
#pragma unroll
                    for (int n = 0; n < 2; ++n) acc[a][b][m][n] = (f32x4){0.f, 0.f, 0.f, 0.f};
        cur = nxt; cA = nA; cB = nB; ++ui;
    }
    PG8_WAIT_V(0);
    if (wr == 0) PG8_BAR;
    PG8_BAR;
#undef PG8_SA
#undef PG8_SB
#undef PG8_STAGE
#undef PG8_LDA
#undef PG8_LDB
#undef PG8_MMA
#undef PG8_WAIT_V
#undef PG8_WAIT_L
#undef PG8_BAR
#undef PG8_SCHED
}
}
using pg8::Unit;

struct EpiP {
    static constexpr bool PERM = true;
    bf16_t* P; bf16_t* GT;
    __device__ __forceinline__ void operator()(const f32x4 (&acc)[2][2][4][2], const Unit& u, int wr, int wc, int fr, int fq) const {
        const int row0 = u.pm * 256 + wr * 64 + fr;
        if (u.pn >= 22 && u.pn < 34) {
            u32x4* gt = (u32x4*)GT + ((size_t)(u.pm * 12 + (u.pn - 22)) * 16) * 512 + ((wr * 4 + wc) * 64 + fq * 16 + fr);
#pragma unroll
            for (int bj = 0; bj < 2; ++bj)
#pragma unroll
                for (int ai = 0; ai < 2; ++ai)
#pragma unroll
                    for (int m = 0; m < 4; ++m) {
                        const f32x4 v0 = acc[ai][bj][m][0], v1 = acc[ai][bj][m][1];
                        u32x4 w; w.x = cvt_pk_bf16(sigmoidf_(v0[0]), sigmoidf_(v0[1])); w.y = cvt_pk_bf16(sigmoidf_(v0[2]), sigmoidf_(v0[3]));
                        w.z = cvt_pk_bf16(sigmoidf_(v1[0]), sigmoidf_(v1[1])); w.w = cvt_pk_bf16(sigmoidf_(v1[2]), sigmoidf_(v1[3]));
                        gt[(size_t)((bj * 2 + ai) * 4 + m) * 512] = w;
                    }
            return;
        }
        const bool sig = false;
#pragma unroll
        for (int bj = 0; bj < 2; ++bj) {
            const int c0 = (u.pn < 22 ? u.pn * 256 : C_LR) + bj * 128 + wc * 32 + 8 * fq;
            if (u.pn >= 22 && (bj * 128 + wc * 32 + 8 * fq) >= 32) continue;
#pragma unroll
            for (int ai = 0; ai < 2; ++ai)
#pragma unroll
                for (int m = 0; m < 4; ++m) {
                    f32x4 v0 = acc[ai][bj][m][0], v1 = acc[ai][bj][m][1];
                    if (sig) {
#pragma unroll
                        for (int j = 0; j < 4; ++j) { v0[j] = sigmoidf_(v0[j]); v1[j] = sigmoidf_(v1[j]); }
                    }
                    u32x4 w; w.x = cvt_pk_bf16(v0[0], v0[1]); w.y = cvt_pk_bf16(v0[2], v0[3]); w.z = cvt_pk_bf16(v1[0], v1[1]); w.w = cvt_pk_bf16(v1[2], v1[3]);
                    *(u32x4*)(P + (size_t)(row0 + ai * 128 + m * 16) * LDP + c0) = w;
                }
        }
    }
};
struct EpiMerge {
    static constexpr bool PERM = true;
    const bf16_t* GT; bf16_t* PT; bf16_t* PT2;
    __device__ __forceinline__ void operator()(const f32x4 (&acc)[2][2][4][2], const Unit& u, int wr, int wc, int fr, int fq) const {
        const int b = u.b, tslot = (wr * 4 + wc) * 64 + fq * 16 + fr;
        const u32x4* gt = (const u32x4*)GT + ((size_t)(u.pm * 12 + b * 4 + u.pn) * 16) * 512 + tslot;
        u32x4* pt = (u32x4*)(b == 2 ? PT2 : PT) + ((size_t)(u.pm * 4 + u.pn) * 16) * 512 + tslot;
#pragma unroll
        for (int bj = 0; bj < 2; ++bj)
#pragma unroll
            for (int ai = 0; ai < 2; ++ai)
#pragma unroll
                for (int m = 0; m < 4; ++m) {
                    const int idx = (bj * 2 + ai) * 4 + m;
                    const u32x4 g = gt[(size_t)idx * 512];
                    u32x4 pv = (u32x4){0u, 0u, 0u, 0u};
                    if (b == 1) pv = pt[(size_t)idx * 512];
                    const f32x4 v0 = acc[ai][bj][m][0], v1 = acc[ai][bj][m][1];
                    u32x4 w;
                    w.x = cvt_pk_bf16(bflo(pv.x) + bflo(g.x) * v0[0], bfhi(pv.x) + bfhi(g.x) * v0[1]);
                    w.y = cvt_pk_bf16(bflo(pv.y) + bflo(g.y) * v0[2], bfhi(pv.y) + bfhi(g.y) * v0[3]);
                    w.z = cvt_pk_bf16(bflo(pv.z) + bflo(g.z) * v1[0], bfhi(pv.z) + bfhi(g.z) * v1[1]);
                    w.w = cvt_pk_bf16(bflo(pv.w) + bflo(g.w) * v1[2], bfhi(pv.w) + bfhi(g.w) * v1[3]);
                    pt[(size_t)idx * 512] = w;
                }
    }
};
__device__ __forceinline__ void phase_combine(const bf16_t* PT, const bf16_t* PT2, bf16_t* Mg, int b0, int nb) {
    const int tid = otid();
    if ((int)blockIdx.x < b0 || (int)blockIdx.x >= b0 + nb) return;
    for (int e = ((int)blockIdx.x - b0) * 512 + tid; e < 128 * 16 * 512; e += nb * 512) {
        const u32x4 a = ((const u32x4*)PT)[e], c = ((const u32x4*)PT2)[e];
        const int tslot = e & 511, idx = (e >> 9) & 15, tile = e >> 13, pm = tile >> 2, pn = tile & 3;
        const int wv = tslot >> 6, ln = tslot & 63, wr = wv >> 2, wc = wv & 3, fq = ln >> 4, fr = ln & 15;
        const int bj = idx >> 3, ai = (idx >> 2) & 1, m = idx & 3;
        const int row = pm * 256 + ai * 128 + wr * 64 + m * 16 + fr, c0 = pn * 256 + bj * 128 + wc * 32 + 8 * fq;
        u32x4 w;
        w.x = cvt_pk_bf16(bflo(a.x) + bflo(c.x), bfhi(a.x) + bfhi(c.x)); w.y = cvt_pk_bf16(bflo(a.y) + bflo(c.y), bfhi(a.y) + bfhi(c.y));
        w.z = cvt_pk_bf16(bflo(a.z) + bflo(c.z), bfhi(a.z) + bfhi(c.z)); w.w = cvt_pk_bf16(bflo(a.w) + bflo(c.w), bfhi(a.w) + bfhi(c.w));
        *(u32x4*)(Mg + (size_t)row * 1024 + c0) = w;
    }
}
template <bool IN_F32>
struct EpiResid {
    static constexpr bool PERM = false;
    const void* xin; bf16_t* xout; const float* gate;
    __device__ __forceinline__ void operator()(const f32x4 (&acc)[2][2][4][2], const Unit& u, int wr, int wc, int fr, int fq) const {
        const int row0 = u.pm * 256 + wr * 64 + fr, col0 = u.pn * 256 + wc * 32 + 4 * fq;
        const int bidx = (u.pm * 256) >> 12;
        f32x4 gv[2][2];
#pragma unroll
        for (int bj = 0; bj < 2; ++bj)
#pragma unroll
            for (int n = 0; n < 2; ++n) gv[bj][n] = *(const f32x4*)(gate + bidx * 6144 + col0 + bj * 128 + n * 16);
#pragma unroll
        for (int ai = 0; ai < 2; ++ai)
#pragma unroll
            for (int m = 0; m < 4; ++m) {
                const size_t ro = (size_t)(row0 + ai * 128 + m * 16) * 1024 + col0;
#pragma unroll
                for (int bj = 0; bj < 2; ++bj)
#pragma unroll
                    for (int n = 0; n < 2; ++n) {
                        f32x4 xv;
                        if (IN_F32) xv = *(const f32x4*)((const float*)xin + ro + bj * 128 + n * 16);
                        else { const u32x2 xb = *(const u32x2*)((const bf16_t*)xin + ro + bj * 128 + n * 16); xv = (f32x4){bflo(xb.x), bfhi(xb.x), bflo(xb.y), bfhi(xb.y)}; }
                        const f32x4 y = xv + gv[bj][n] * acc[ai][bj][m][n];
                        u32x2 o; o.x = cvt_pk_bf16(y[0], y[1]); o.y = cvt_pk_bf16(y[2], y[3]);
                        *(u32x2*)(xout + ro + bj * 128 + n * 16) = o;
                    }
            }
    }
};
struct EpiGU {
    static constexpr bool PERM = false;
    bf16_t* Hid;
    __device__ __forceinline__ void operator()(const f32x4 (&acc)[2][2][4][2], const Unit& u, int wr, int wc, int fr, int fq) const {
        const int row0 = u.pm * 256 + wr * 64 + fr, hc0 = u.pn * 128 + wc * 16 + 4 * fq;
#pragma unroll
        for (int ai = 0; ai < 2; ++ai)
#pragma unroll
            for (int m = 0; m < 4; ++m)
#pragma unroll
                for (int bj = 0; bj < 2; ++bj) {
                    const f32x4 gt = acc[ai][bj][m][0], up = acc[ai][bj][m][1];
                    u32x2 w; w.x = cvt_pk_bf16(siluf_(gt[0]) * up[0], siluf_(gt[1]) * up[1]); w.y = cvt_pk_bf16(siluf_(gt[2]) * up[2], siluf_(gt[3]) * up[3]);
                    *(u32x2*)(Hid + (size_t)(row0 + ai * 128 + m * 16) * FF + hc0 + bj * 64) = w;
                }
    }
};

template <class Epi>
__device__ __forceinline__ void run_gemm(unsigned char* smem, const bf16_t* A, int lda, const bf16_t* Bt, int Mrows, int N, int K, const Epi& E) {
    pg8::Gemm g{A, lda, Bt, Mrows, N, K, 0, 0};
    pg8::StaticOrder S; S.init(Mrows, N, (int)gridDim.x, (int)blockIdx.x);
    pg8::gemm_phase<Epi, pg8::StaticOrder>((LAS unsigned char*)smem, g, S, E);
}

__device__ __forceinline__ void phase_prep(const Params& p, unsigned char* smem) {
    const int tid = otid();
    float* cact = (float*)smem;
    float* red = cact + 4096;
    for (int i = tid; i < 4096; i += 512) cact[i] = siluf_(p.in[1][i]);
    __syncthreads();
    float* mod = (float*)(p.ws + WS_MOD);
    for (int item = blockIdx.x; item < 192; item += gridDim.x) {
        const int l = item / 96, cb = item % 96, col = cb * 64 + (tid & 63), kg = tid >> 6;
        const float* W = p.in[2] + (size_t)l * 1024 * 6144 + col;
        float a0 = 0.f, a1 = 0.f, a2 = 0.f, a3 = 0.f;
#pragma unroll 16
        for (int k = kg * 128; k < kg * 128 + 128; ++k) {
            const float w = __builtin_nontemporal_load(W + (size_t)k * 6144);
            a0 += cact[k] * w; a1 += cact[1024 + k] * w; a2 += cact[2048 + k] * w; a3 += cact[3072 + k] * w;
        }
        red[(kg * 4 + 0) * 64 + (tid & 63)] = a0; red[(kg * 4 + 1) * 64 + (tid & 63)] = a1;
        red[(kg * 4 + 2) * 64 + (tid & 63)] = a2; red[(kg * 4 + 3) * 64 + (tid & 63)] = a3;
        __syncthreads();
        if (tid < 256) {
            const int b = tid >> 6, c = tid & 63;
            float s = p.in[3][l * 6144 + cb * 64 + c];
#pragma unroll
            for (int g = 0; g < 8; ++g) s += red[(g * 4 + b) * 64 + c];
            mod[(l * 4 + b) * 6144 + cb * 64 + c] = s;
        }
        __syncthreads();
    }
    float* lb = (float*)(p.ws + WS_LB);
    for (int j = blockIdx.x * 512 + tid; j < 1024; j += gridDim.x * 512) {
        const float l0 = p.in[10][j], l1 = p.in[10][1024 + j];
        const float mx = fmaxf(l0, l1), e0 = __expf(l0 - mx), e1 = __expf(l1 - mx), inv = 1.f / (e0 + e1);
        const float p0 = e0 * inv, p1 = e1 * inv;
        lb[j] = fminf(fmaxf(p0 - p0, 0.f), 1.f);
        lb[1024 + j] = fminf(fmaxf((p0 + p1) - p0, 0.f), 1.f);
    }
}

__device__ __forceinline__ void convert_item(const Params& p, int l, int mat, int tileidx, float* scr, int lane) {
    int K; bf16_t* dst;
    switch (mat) {
        case 0: K = 1024; dst = (bf16_t*)(p.ws + WS_WIN); break;
        case 1: case 2: case 3: K = 512; dst = (bf16_t*)(p.ws + WS_WPROJ) + (size_t)(mat - 1) * 1024 * 512; break;
        case 4: K = 1024; dst = (bf16_t*)(p.ws + WS_WOUT); break;
        case 5: K = 1024; dst = (bf16_t*)(p.ws + WS_WGU); break;
        default: K = 2816; dst = (bf16_t*)(p.ws + WS_WDN); break;
    }
    const int nkt = K / 64, n0 = (tileidx / nkt) * 32, k0 = (tileidx % nkt) * 64;
    {
        const int n = n0 + (lane & 31);
        const float* src = nullptr; int ld = 0;
        switch (mat) {
            case 0: { int col = -1; if (n < 3072) col = n; else if (n < 8704) col = n + 32; else if (n < 8736) col = n - 8704 + 3072;
                      if (col >= 0) src = p.in[5] + (size_t)l * 1024 * 8736 + col; ld = 8736; break; }
            case 1: src = p.in[12] + (size_t)l * 512 * 1024 + n; ld = 1024; break;
            case 2: src = p.in[13] + (size_t)l * 512 * 1024 + n; ld = 1024; break;
            case 3: src = p.in[14] + (size_t)l * 512 * 1024 + n; ld = 1024; break;
            case 4: src = p.in[15] + (size_t)l * 1024 * 1024 + n; ld = 1024; break;
            case 5: { const int G = n >> 5, r = n & 31; src = (r < 16 ? p.in[17] : p.in[18]) + (size_t)l * 1024 * 2816 + 16 * G + (r & 15); ld = 2816; break; }
            default: src = p.in[19] + (size_t)l * 2816 * 1024 + n; ld = 1024; break;
        }
        float v[32];
#pragma unroll
        for (int i = 0; i < 32; ++i) { const int kk = 2 * i + (lane >> 5); v[i] = src ? __builtin_nontemporal_load(src + (size_t)(k0 + kk) * ld) : 0.f; }
#pragma unroll
        for (int i = 0; i < 32; ++i) { const int kk = 2 * i + (lane >> 5); scr[kk * 33 + (lane & 31)] = v[i]; }
    }
    asm volatile("s_waitcnt lgkmcnt(0)" ::: "memory"); __builtin_amdgcn_wave_barrier();
    {
        const int c = lane & 7;
#pragma unroll
        for (int j = 0; j < 4; ++j) {
            const int n = (lane >> 3) + 8 * j; const float* s = scr + (8 * c) * 33 + n;
            u32x4 o; o.x = cvt_pk_bf16(s[0], s[33]); o.y = cvt_pk_bf16(s[2 * 33], s[3 * 33]); o.z = cvt_pk_bf16(s[4 * 33], s[5 * 33]); o.w = cvt_pk_bf16(s[6 * 33], s[7 * 33]);
            *(u32x4*)(dst + (size_t)(n0 + n) * K + k0 + 8 * c) = o;
        }
    }
    asm volatile("s_waitcnt lgkmcnt(0)" ::: "memory"); __builtin_amdgcn_wave_barrier();
}
__device__ __forceinline__ void phase_convert(const Params& p, int l, unsigned char* smem) {
    const int tid = otid(), wave = __builtin_amdgcn_readfirstlane(tid >> 6), lane = tid & 63;
    float* scr = (float*)(smem + 32768 + wave * 8704);
    constexpr int I0 = 280 * 16, I1 = 32 * 8, I4 = 32 * 16, I5 = 176 * 16, I6 = 32 * 44;
    constexpr int NIT = I0 + 3 * I1 + I4 + I5 + I6;
    for (int it = blockIdx.x * 8 + wave; it < NIT; it += gridDim.x * 8) {
        int r = it;
        if (r < I0) { convert_item(p, l, 0, r, scr, lane); continue; } r -= I0;
        if (r < I1) { convert_item(p, l, 1, r, scr, lane); continue; } r -= I1;
        if (r < I1) { convert_item(p, l, 2, r, scr, lane); continue; } r -= I1;
        if (r < I1) { convert_item(p, l, 3, r, scr, lane); continue; } r -= I1;
        if (r < I4) { convert_item(p, l, 4, r, scr, lane); continue; } r -= I4;
        if (r < I5) { convert_item(p, l, 5, r, scr, lane); continue; } r -= I5;
        convert_item(p, l, 6, r, scr, lane);
    }
}

template <bool IN_F32>
__device__ __forceinline__ void load_row16(const void* x, size_t row, int lane, f32x4 (&v)[4]) {
    if (IN_F32) {
        const f32x4* xr = (const f32x4*)((const float*)x + row * 1024) + lane;
#pragma unroll
        for (int j = 0; j < 4; ++j) v[j] = xr[64 * j];
    } else {
        const u32x2* xr = (const u32x2*)((const bf16_t*)x + row * 1024) + lane;
#pragma unroll
        for (int j = 0; j < 4; ++j) { const u32x2 w = xr[64 * j]; v[j] = (f32x4){bflo(w.x), bfhi(w.x), bflo(w.y), bfhi(w.y)}; }
    }
}
template <bool IN_F32>
__device__ __forceinline__ void phase_modnorm(const void* x, bf16_t* dst, int row0, int nrows, const float* nw, const float* shift, const float* scale, int b0 = 0, int nb = 0) {
    if (nb == 0) nb = (int)gridDim.x;
    if ((int)blockIdx.x < b0 || (int)blockIdx.x >= b0 + nb) return;
    const int tid_ = otid(); const int lane = tid_ & 63, gw = ((int)blockIdx.x - b0) * 8 + (tid_ >> 6), ngw = nb * 8;
    for (int rb = gw * 4; rb < nrows; rb += ngw * 4) {
        f32x4 v[4][4];
#pragma unroll
        for (int q = 0; q < 4; ++q) load_row16<IN_F32>(x, (size_t)(row0 + rb + q), lane, v[q]);
#pragma unroll
        for (int q = 0; q < 4; ++q) {
            const int r = rb + q, b = (row0 + r) >> 12;
            float ss = 0.f;
#pragma unroll
            for (int j = 0; j < 4; ++j) ss += (v[q][j][0] * v[q][j][0] + v[q][j][1] * v[q][j][1]) + (v[q][j][2] * v[q][j][2] + v[q][j][3] * v[q][j][3]);
            const float rstd = rsqrtf(wave_sum(ss) * (1.f / 1024.f) + 1e-6f);
#pragma unroll
            for (int j = 0; j < 4; ++j) {
                const int c = lane * 4 + 256 * j;
                const f32x4 w4 = *(const f32x4*)(nw + c), sc = *(const f32x4*)(scale + b * 6144 + c), sh = *(const f32x4*)(shift + b * 6144 + c);
                const f32x4 y = v[q][j] * rstd * w4 * (sc + 1.f) + sh;
                u32x2 o; o.x = cvt_pk_bf16(y[0], y[1]); o.y = cvt_pk_bf16(y[2], y[3]);
                *(u32x2*)(dst + (size_t)r * 1024 + c) = o;
            }
        }
    }
}
__device__ __forceinline__ void phase_finalnorm(const bf16_t* x, float* out, const float* nw) {
    const int tid_ = otid(); const int lane = tid_ & 63, gw = blockIdx.x * 8 + (tid_ >> 6), ngw = gridDim.x * 8;
    for (int rb = gw * 4; rb < M; rb += ngw * 4) {
        f32x4 v[4][4];
#pragma unroll
        for (int q = 0; q < 4; ++q) load_row16<false>(x, (size_t)(rb + q), lane, v[q]);
#pragma unroll
        for (int q = 0; q < 4; ++q) {
            f32x4* xr = (f32x4*)(out + (size_t)(rb + q) * 1024) + lane;
            float ss = 0.f;
#pragma unroll
            for (int j = 0; j < 4; ++j) ss += (v[q][j][0] * v[q][j][0] + v[q][j][1] * v[q][j][1]) + (v[q][j][2] * v[q][j][2] + v[q][j][3] * v[q][j][3]);
            const float rstd = rsqrtf(wave_sum(ss) * (1.f / 1024.f) + 1e-6f);
#pragma unroll
            for (int j = 0; j < 4; ++j) { const f32x4 w4 = *(const f32x4*)(nw + lane * 4 + 256 * j); __builtin_nontemporal_store(v[q][j] * rstd * w4, xr + 64 * j); }
        }
    }
}
__device__ __forceinline__ void phase_zero(float* buf, size_t n4) {
    f32x4* b4 = (f32x4*)buf;
    const int tid_ = otid();
    for (size_t i = (size_t)blockIdx.x * 512 + tid_; i < n4; i += (size_t)gridDim.x * 512) b4[i] = (f32x4){0.f, 0.f, 0.f, 0.f};
}

typedef short bf16x4 __attribute__((ext_vector_type(4)));
__device__ __forceinline__ bf16x4 lds_tr16(const bf16_t* p) { return __builtin_amdgcn_ds_read_tr16_b64_v4i16((LAS bf16x4*)p); }
constexpr float LOG2E = 1.44269504088896341f;
#define DPP_SHR_ADD(x, n) x += __int_as_float(__builtin_amdgcn_update_dpp(0, __float_as_int(x), 0x110 + (n), 0xf, 0xf, true))
__device__ __forceinline__ float row_scan16(float x) { DPP_SHR_ADD(x, 1); DPP_SHR_ADD(x, 2); DPP_SHR_ADD(x, 4); DPP_SHR_ADD(x, 8); return x; }
__device__ __forceinline__ bf16x4 pack4(float a, float b, float c, float d) { u32x2 w; w.x = cvt_pk_bf16(a, b); w.y = cvt_pk_bf16(c, d); return __builtin_bit_cast(bf16x4, w); }
__device__ __forceinline__ bf16x8 pack8(float a0, float a1, float a2, float a3, float b0, float b1, float b2, float b3) {
    u32x4 w; w.x = cvt_pk_bf16(a0, a1); w.y = cvt_pk_bf16(a2, a3); w.z = cvt_pk_bf16(b0, b1); w.w = cvt_pk_bf16(b2, b3); return __builtin_bit_cast(bf16x8, w); }
#define WAVE_FENCE() do { asm volatile("s_waitcnt lgkmcnt(0)" ::: "memory"); __builtin_amdgcn_wave_barrier(); } while (0)

template <int BR, int PASS>
__device__ __forceinline__ void scan_wave_item(const Params& p, int l, const bf16_t* P, float* OACC, bf16_t* OB, int item, bf16_t* ldsw, bf16_t* ldsv, float* xbuf, int wave) {
    constexpr int NT = 2, NU = 1, NVT = 8;
    const int lane = otid() & 63, i = lane & 15, g = lane >> 4;
    const int sc = item & 15, cs = item >> 4;
    int ds, dir, h, bl;
    if (BR == 0) { ds = cs & 1; dir = (cs >> 1) & 1; h = (cs >> 2) & 3; bl = cs >> 4; }
    else { ds = cs & 3; dir = (cs >> 2) & 1; h = (cs >> 3) & 3; bl = cs >> 5; }
    const int d0 = ds * 32;
    const int gid = (BR ? 512 : 0) + item;
    bf16_t* SLOC = (bf16_t*)(p.ws + WS_SLOC); float* LAb = (float*)(p.ws + WS_LA);
    float cst[NT][4];
    bf16x4 upA[NT];
#pragma unroll
    for (int t = 0; t < NT; ++t) {
#pragma unroll
        for (int r = 0; r < 4; ++r) {
            const int d = 16 * t + 4 * g + r;
            cst[t][r] = BR ? ((const float*)(p.ws + WS_LB))[l * 1024 + dir * 512 + h * 128 + d0 + d] : p.in[8][(l * 2 + dir) * 256 + h * 64 + d0 + d];
        }
        if (BR == 0) {
            const float* upp = p.in[7] + ((size_t)(l * 2 + dir) * 16 + 4 * g) * 256 + h * 64 + d0 + 16 * t + i;
            upA[t] = pack4(upp[0], upp[256], upp[512], upp[768]);
        } else upA[t] = (bf16x4){0, 0, 0, 0};
    }
    f32x4 S[NT][NVT];
    float LAsum[NT][4];
#pragma unroll
    for (int t = 0; t < NT; ++t) {
#pragma unroll
        for (int r = 0; r < 4; ++r) LAsum[t][r] = 0.f;
#pragma unroll
        for (int vt = 0; vt < NVT; ++vt) S[t][vt] = (f32x4){0.f, 0.f, 0.f, 0.f};
    }
    if (PASS == 3) {
        float dec[NT][4];
#pragma unroll
        for (int t = 0; t < NT; ++t)
#pragma unroll
            for (int r = 0; r < 4; ++r) dec[t][r] = 1.f;
#pragma unroll 2
        for (int s2 = sc - 1; s2 >= 0; --s2) {
            const int g2 = gid - sc + s2;
            const float* lap = LAb + (size_t)g2 * 128 + g * 32;
            const u32x4* sp = (const u32x4*)(SLOC + (size_t)g2 * 4096) + lane;
            u32x4 w[8];
#pragma unroll
            for (int k = 0; k < 8; ++k) w[k] = sp[64 * k];
#pragma unroll
            for (int t = 0; t < NT; ++t) {
                const f32x4 la4 = *(const f32x4*)(lap + 4 * t);
#pragma unroll
                for (int vt = 0; vt < NVT; ++vt) {
                    const int idx = (t * NVT + vt) * 4, k = idx >> 3, hf = (idx >> 2) & 1;
                    const unsigned w0 = hf ? w[k].z : w[k].x, w1 = hf ? w[k].w : w[k].y;
                    S[t][vt][0] += dec[t][0] * bflo(w0); S[t][vt][1] += dec[t][1] * bfhi(w0);
                    S[t][vt][2] += dec[t][2] * bflo(w1); S[t][vt][3] += dec[t][3] * bfhi(w1);
                }
#pragma unroll
                for (int r = 0; r < 4; ++r) dec[t][r] *= __builtin_amdgcn_exp2f(la4[r]);
            }
        }
    }
    const int qc = (BR ? (C_HQ + h * 128) : (C_GQ + h * 64)) + d0, kc = (BR ? (C_HF + dir * 512 + h * 128) : (C_GK + h * 64)) + d0;
    const int vcol = (BR ? C_HI : C_GV) + h * 128 + i;
    const int ocol = BR * 512 + h * 128 + i;
    u32x2 krN[NT], qrN[NT]; u32x4 vrN[4]; bf16x4 lrBN = (bf16x4){0, 0, 0, 0};
    const int vcolb = (BR ? C_HI : C_GV) + h * 128;
#define SCAN_LOAD(n_) do { const int pos0_ = sc * 256 + (n_) * 16; const int tt_ = dir ? (T - 1 - (pos0_ + i)) : (pos0_ + i); \
        const bf16_t* prow_ = P + (size_t)(bl * 4096 + tt_) * LDP; \
        _Pragma("unroll") for (int t_ = 0; t_ < NT; ++t_) { krN[t_] = *(const u32x2*)(prow_ + kc + 16 * t_ + 4 * g); \
            if (PASS == 3) qrN[t_] = *(const u32x2*)(prow_ + qc + 16 * t_ + 4 * g); else qrN[t_] = (u32x2){0u, 0u}; } \
        if (BR == 0) lrBN = *(const bf16x4*)(prow_ + C_LR + dir * 16 + 4 * g); \
        _Pragma("unroll") for (int x_ = 0; x_ < 4; ++x_) vrN[x_] = *(const u32x4*)(prow_ + vcolb + 32 * g + 8 * x_); } while (0)
    SCAN_LOAD(0);
    for (int n = 0; n < 16; ++n) {
        const int pos0 = sc * 256 + n * 16;
        u32x2 krC[NT], qrC[NT]; bf16x4 Vb[NVT]; const bf16x4 lrB = lrBN;
#pragma unroll
        for (int t = 0; t < NT; ++t) { krC[t] = krN[t]; qrC[t] = qrN[t]; }
        {
#pragma unroll
            for (int x = 0; x < 4; ++x) *(u32x4*)(ldsv + i * 144 + 32 * g + 8 * x) = vrN[x];
            WAVE_FENCE();
            const bf16_t* tp = ldsv + (4 * g + ((lane >> 2) & 3)) * 144 + 4 * (lane & 3);
#pragma unroll
            for (int vt = 0; vt < NVT; ++vt) Vb[vt] = lds_tr16(tp + 16 * vt);
            WAVE_FENCE();
        }
        if (n + 1 < 16) SCAN_LOAD(n + 1);
        f32x4 sT = (f32x4){0.f, 0.f, 0.f, 0.f};
        f32x4 o[NVT];
#pragma unroll
        for (int vt = 0; vt < NVT; ++vt) o[vt] = (f32x4){0.f, 0.f, 0.f, 0.f};
#pragma unroll
        for (int u = 0; u < NU; ++u) {
            float kv[8], qv[8], la[8];
            u32x2 kr[2], qr[2];
#pragma unroll
            for (int x = 0; x < 2; ++x) { kr[x] = krC[2 * u + x]; qr[x] = qrC[2 * u + x]; }
#pragma unroll
            for (int x = 0; x < 2; ++x) {
                const int t = 2 * u + x;
                const float k0 = bflo(kr[x].x), k1 = bfhi(kr[x].x), k2 = bflo(kr[x].y), k3 = bfhi(kr[x].y);
                const float q0 = bflo(qr[x].x), q1 = bfhi(qr[x].x), q2 = bflo(qr[x].y), q3 = bfhi(qr[x].y);
                const float kk[4] = {k0, k1, k2, k3}, qq[4] = {q0, q1, q2, q3};
                if (BR == 0) {
                    const f32x4 z = __builtin_amdgcn_mfma_f32_16x16x16bf16_1k(upA[t], lrB, (f32x4){cst[t][0], cst[t][1], cst[t][2], cst[t][3]}, 0, 0, 0);
#pragma unroll
                    for (int r = 0; r < 4; ++r) {
                        la[4 * x + r] = (fminf(z[r], 0.f) * LOG2E - __builtin_amdgcn_logf(1.f + __builtin_amdgcn_exp2f(-fabsf(z[r]) * LOG2E))) * (1.f / 16.f);
                        kv[4 * x + r] = kk[r]; qv[4 * x + r] = qq[r] * 0.125f;
                    }
                } else {
#pragma unroll
                    for (int r = 0; r < 4; ++r) {
                        const float z = fminf(fmaxf(kk[r], -80.f), 80.f), lbv = cst[t][r];
                        const float ez = __builtin_amdgcn_exp2f(-z * LOG2E), sg = __builtin_amdgcn_rcpf(1.f + ez), sn = ez * sg;
                        la[4 * x + r] = __builtin_amdgcn_logf(fmaxf(lbv + (1.f - lbv) * sg, 1e-30f));
                        kv[4 * x + r] = (1.f - lbv) * sn;
                        qv[4 * x + r] = qq[r] * __builtin_amdgcn_rcpf(1.f + __builtin_amdgcn_exp2f(-qq[r] * LOG2E));
                    }
                }
            }
            float bb[8], bl_[8];
#pragma unroll
            for (int e = 0; e < 8; ++e) { bb[e] = row_scan16(la[e]); bl_[e] = __shfl(bb[e], (lane & 48) | 15); }
            {
                float kd[8];
#pragma unroll
                for (int e = 0; e < 8; ++e) kd[e] = kv[e] * __builtin_amdgcn_exp2f(bl_[e] - bb[e]);
#pragma unroll
                for (int x = 0; x < 2; ++x) {
                    u32x2 w2; w2.x = cvt_pk_bf16(kd[4 * x], kd[4 * x + 1]); w2.y = cvt_pk_bf16(kd[4 * x + 2], kd[4 * x + 3]);
                    *(u32x2*)(ldsw + i * 36 + 16 * (2 * u + x) + 4 * g) = w2;
                }
            }
            if (PASS == 3) {
                float qt[8], kt[8], qd[8];
#pragma unroll
                for (int e = 0; e < 8; ++e) {
                    const float bm = __shfl(bb[e], (lane & 48) | 7);
                    qt[e] = qv[e] * __builtin_amdgcn_exp2f(bb[e] - bm); kt[e] = kv[e] * __builtin_amdgcn_exp2f(bm - bb[e]); qd[e] = qv[e] * __builtin_amdgcn_exp2f(bb[e]);
                }
                const bf16x8 kt8 = pack8(kt[0], kt[1], kt[2], kt[3], kt[4], kt[5], kt[6], kt[7]);
                const bf16x8 qt8 = pack8(qt[0], qt[1], qt[2], qt[3], qt[4], qt[5], qt[6], qt[7]);
                const bf16x8 qd8 = pack8(qd[0], qd[1], qd[2], qd[3], qd[4], qd[5], qd[6], qd[7]);
                sT = __builtin_amdgcn_mfma_f32_16x16x32_bf16(kt8, qt8, sT, 0, 0, 0);
#pragma unroll
                for (int vt = 0; vt < NVT; ++vt) {
                    const f32x4 sa = S[2 * u][vt], sb = S[2 * u + 1][vt];
                    const bf16x8 sb8 = pack8(sa[0], sa[1], sa[2], sa[3], sb[0], sb[1], sb[2], sb[3]);
                    o[vt] = __builtin_amdgcn_mfma_f32_16x16x32_bf16(qd8, sb8, o[vt], 0, 0, 0);
                }
            }
            WAVE_FENCE();
#pragma unroll
            for (int x = 0; x < 2; ++x) {
                const int t = 2 * u + x;
                const bf16x4 kdT = lds_tr16(ldsw + (4 * g + ((lane >> 2) & 3)) * 36 + 16 * t + 4 * (lane & 3));
                float a[4];
#pragma unroll
                for (int r = 0; r < 4; ++r) { a[r] = __builtin_amdgcn_exp2f(bl_[4 * x + r]); if (PASS == 1) LAsum[t][r] += bl_[4 * x + r]; }
#pragma unroll
                for (int vt = 0; vt < NVT; ++vt) {
                    f32x4 c = S[t][vt];
                    c[0] *= a[0]; c[1] *= a[1]; c[2] *= a[2]; c[3] *= a[3];
                    S[t][vt] = __builtin_amdgcn_mfma_f32_16x16x16bf16_1k(kdT, Vb[vt], c, 0, 0, 0);
                }
            }
            WAVE_FENCE();
        }
        if (PASS == 3) {
            size_t vro[4];
#pragma unroll
            for (int r = 0; r < 4; ++r) { const int pp = pos0 + 4 * g + r; vro[r] = (size_t)(bl * 4096 + (dir ? (T - 1 - pp) : pp)); }
            const bf16x4 Pm = pack4((4 * g + 0 <= i) ? sT[0] : 0.f, (4 * g + 1 <= i) ? sT[1] : 0.f, (4 * g + 2 <= i) ? sT[2] : 0.f, (4 * g + 3 <= i) ? sT[3] : 0.f);
#pragma unroll
            for (int vt = 0; vt < NVT; ++vt) {
                o[vt] = __builtin_amdgcn_mfma_f32_16x16x16bf16_1k(Pm, Vb[vt], o[vt], 0, 0, 0);
            }
#pragma unroll
            for (int vt = 0; vt < NVT; ++vt)
#pragma unroll
                for (int r = 0; r < 4; ++r) xbuf[(wave * 32 + vt * 4 + r) * 64 + lane] = o[vt][r];
            __syncthreads();
            {
                constexpr int NPART = BR ? 4 : 2, NMINE = 8 / NPART;
                const int wg = wave & 3, pbase = BR ? (wave & ~3) : (wave & ~1), vt0 = (BR ? wg : (wg & 1)) * NMINE;
#pragma unroll
                for (int m = 0; m < NMINE; ++m) {
                    const int vt = vt0 + m;
#pragma unroll
                    for (int r = 0; r < 4; ++r) {
                        float s = 0.f;
#pragma unroll
                        for (int q = 0; q < NPART; ++q) s += xbuf[((pbase + q) * 32 + vt * 4 + r) * 64 + lane];
                        if (dir == 0) OACC[vro[r] * 1024 + ocol + 16 * vt] = s;
                        else OB[vro[r] * 1024 + ocol + 16 * vt] = (bf16_t)(cvt_pk_bf16(s, s) & 0xffffu);
                    }
                }
            }
            __syncthreads();
        }
    }
    if (PASS == 1) {
        u32x4* sp = (u32x4*)(SLOC + (size_t)gid * 4096) + lane;
        unsigned wv[32];
#pragma unroll
        for (int t = 0; t < NT; ++t)
#pragma unroll
            for (int vt = 0; vt < NVT; ++vt) {
                const int idx = (t * NVT + vt) * 4;
                wv[idx >> 1] = cvt_pk_bf16(S[t][vt][0], S[t][vt][1]); wv[(idx >> 1) + 1] = cvt_pk_bf16(S[t][vt][2], S[t][vt][3]);
            }
#pragma unroll
        for (int k = 0; k < 8; ++k) sp[64 * k] = (u32x4){wv[4 * k], wv[4 * k + 1], wv[4 * k + 2], wv[4 * k + 3]};
        if (i == 0) {
            float* lap = LAb + (size_t)gid * 128 + g * 32;
#pragma unroll
            for (int t = 0; t < NT; ++t) *(f32x4*)(lap + 4 * t) = (f32x4){LAsum[t][0], LAsum[t][1], LAsum[t][2], LAsum[t][3]};
        }
    }
}

__device__ __forceinline__ void na_wave_item(bf16_t* P, int item, bf16_t* ldsw, const float* rpbL) {
    const int lane = otid() & 63, i = lane & 15, g = lane >> 4;
    const int qt = item & 3, r = (item >> 2) & 63, h = (item >> 8) & 7, bl = item >> 11;
    const int rs = min(max(r - 4, 0), 56);
    const int kc0 = (qt == 0) ? 0 : (qt == 1) ? 8 : (qt == 2) ? 24 : 32;
    const int w = 16 * qt + i, cs = min(max(w - 8, 0), 48);
    const bf16_t* qp = P + (size_t)(bl * 4096 + r * 64 + w) * LDP + C_NAQ + h * 64 + 8 * g;
    const bf16x8 q0 = *(const bf16x8*)qp, q1 = *(const bf16x8*)(qp + 32);
    f32x4 sc[8][2];
#pragma unroll
    for (int kt = 0; kt < 2; ++kt) {
        bf16x8 ka[8], kb[8];
#pragma unroll
        for (int j = 0; j < 8; ++j) {
            const bf16_t* kp = P + (size_t)(bl * 4096 + (rs + j) * 64 + kc0 + 16 * kt + i) * LDP + C_NAK + h * 64 + 8 * g;
            ka[j] = *(const bf16x8*)kp; kb[j] = *(const bf16x8*)(kp + 32);
        }
#pragma unroll
        for (int j = 0; j < 8; ++j) {
            const f32x4 a = __builtin_amdgcn_mfma_f32_16x16x32_bf16(ka[j], q0, (f32x4){0.f, 0.f, 0.f, 0.f}, 0, 0, 0);
            sc[j][kt] = __builtin_amdgcn_mfma_f32_16x16x32_bf16(kb[j], q1, a, 0, 0, 0);
        }
    }
    const float* rp = rpbL + h * 465;
    float mx = -1e30f;
#pragma unroll
    for (int j = 0; j < 8; ++j)
#pragma unroll
        for (int kt = 0; kt < 2; ++kt)
#pragma unroll
            for (int rr = 0; rr < 4; ++rr) {
                const int kcol = kc0 + 16 * kt + 4 * g + rr;
                const bool valid = (kcol >= cs) && (kcol < cs + 16);
                const int coff = min(max(kcol - w + 15, 0), 30);
                float s = sc[j][kt][rr] * 0.125f + rp[(rs + j - r + 7) * 31 + coff];
                s = valid ? s : -1e30f;
                sc[j][kt][rr] = s; mx = fmaxf(mx, s);
            }
    mx = fmaxf(mx, __shfl_xor(mx, 16)); mx = fmaxf(mx, __shfl_xor(mx, 32));
    float sum = 0.f;
#pragma unroll
    for (int j = 0; j < 8; ++j)
#pragma unroll
        for (int kt = 0; kt < 2; ++kt)
#pragma unroll
            for (int rr = 0; rr < 4; ++rr) { const float e = __expf(sc[j][kt][rr] - mx); sc[j][kt][rr] = e; sum += e; }
    sum += __shfl_xor(sum, 16); sum += __shfl_xor(sum, 32);
    const float inv = 1.f / sum;
    f32x4 oT[4];
#pragma unroll
    for (int dt = 0; dt < 4; ++dt) oT[dt] = (f32x4){0.f, 0.f, 0.f, 0.f};
    const int vkey = lane & 31, vdh = lane >> 5;
    const bf16_t* vp0 = P + (size_t)(bl * 4096 + rs * 64 + kc0 + vkey) * LDP + C_NAV + h * 64 + vdh * 32;
    u32x4 vn[4];
#pragma unroll
    for (int x = 0; x < 4; ++x) vn[x] = ((const u32x4*)vp0)[x];
#pragma unroll
    for (int j = 0; j < 8; ++j) {
        u32x4 v[4];
#pragma unroll
        for (int x = 0; x < 4; ++x) v[x] = vn[x];
        if (j + 1 < 8) {
#pragma unroll
            for (int x = 0; x < 4; ++x) vn[x] = ((const u32x4*)(vp0 + (size_t)(j + 1) * 64 * LDP))[x];
        }
#pragma unroll
        for (int x = 0; x < 4; ++x) *(u32x4*)(ldsw + vkey * 72 + vdh * 32 + 8 * x) = v[x];
        WAVE_FENCE();
        const bf16x8 p8 = pack8(sc[j][0][0], sc[j][0][1], sc[j][0][2], sc[j][0][3], sc[j][1][0], sc[j][1][1], sc[j][1][2], sc[j][1][3]);
#pragma unroll
        for (int dt = 0; dt < 4; ++dt) {
            const bf16x4 va = lds_tr16(ldsw + (4 * g + ((lane >> 2) & 3)) * 72 + 16 * dt + 4 * (lane & 3)), vb = lds_tr16(ldsw + (16 + 4 * g + ((lane >> 2) & 3)) * 72 + 16 * dt + 4 * (lane & 3));
            const bf16x8 a8 = (bf16x8){va[0], va[1], va[2], va[3], vb[0], vb[1], vb[2], vb[3]};
            oT[dt] = __builtin_amdgcn_mfma_f32_16x16x32_bf16(a8, p8, oT[dt], 0, 0, 0);
        }
        WAVE_FENCE();
    }
    bf16_t* op = P + (size_t)(bl * 4096 + r * 64 + w) * LDP + C_NAQ + h * 64 + 4 * g;
#pragma unroll
    for (int dt = 0; dt < 4; ++dt) {
        u32x2 o2; o2.x = cvt_pk_bf16(oT[dt][0] * inv, oT[dt][1] * inv); o2.y = cvt_pk_bf16(oT[dt][2] * inv, oT[dt][3] * inv);
        *(u32x2*)(op + 16 * dt) = o2;
    }
}

__device__ __forceinline__ void normgate_block(const Params& p, int l, bf16_t* P, const float* OACC, const bf16_t* OB, int tok0, int br, int h0, int nh);
__device__ __forceinline__ void na_phase_body(const Params& p, int l, int half, bf16_t* P, unsigned char* smem) {
    const int tid = otid(), wave = __builtin_amdgcn_readfirstlane(tid >> 6), lane = tid & 63;
    float* rpbL = (float*)(smem + 32768);
    for (int idx = tid; idx < 8 * 465; idx += 512) rpbL[idx] = p.in[6][(size_t)l * 8 * 465 + idx];
    __syncthreads();
    unsigned* ctr = (unsigned*)(p.ws + WS_CTL) + (l * 2 + half) * 16;
    bf16_t* ldsw = (bf16_t*)(smem + 49152 + wave * 4608);
    for (;;) {
        int it = 0;
        if (lane == 0) it = (int)atomicAdd(ctr, 1u);
        it = __builtin_amdgcn_readfirstlane(it);
        if (it >= 1024) break;
        for (int q4 = 0; q4 < 4; ++q4) na_wave_item(P, it * 4 + q4, ldsw, rpbL);
    }
}
__device__ __forceinline__ void phase_scan3(const Params& p, int l, int half, const bf16_t* P, bf16_t* Pw, float* OACC, bf16_t* OB, unsigned char* smem) {
    const int wave = __builtin_amdgcn_readfirstlane(otid() >> 6), wg = wave & 3;
    bf16_t* ldsw = (bf16_t*)(smem + wave * 4096);
    bf16_t* ldsv = (bf16_t*)(smem + 98304 + wave * 4608);
    float* xbuf = (float*)(smem + 32768);
    if (gridDim.x > 192 && blockIdx.x >= 192) {
        na_phase_body(p, l, half, Pw, smem);
        return;
    }
    for (int b = blockIdx.x; b < 192; b += gridDim.x) {
        const int dir = wave >> 2;
        if (b < 128) {
            const int sc0 = b & 15, h = (b >> 4) & 3, bl = b >> 6, sc = dir ? 15 - sc0 : sc0;
            const int cs = wg | (dir << 2) | (h << 3) | (bl << 5);
            scan_wave_item<1, 3>(p, l, P, OACC, OB, cs * 16 + sc, ldsw, ldsv, xbuf, wave);
            asm volatile("s_waitcnt vmcnt(0)" ::: "memory");
            __syncthreads();
            normgate_block(p, l, Pw, OACC, OB, bl * 4096 + sc0 * 256, 1, h, 1);
        } else {
            const int q = b - 128, sc0 = q & 15, hp = (q >> 4) & 1, bl = q >> 5, sc = dir ? 15 - sc0 : sc0;
            const int h = hp * 2 + (wg >> 1), ds = wg & 1;
            const int cs = ds | (dir << 1) | (h << 2) | (bl << 4);
            scan_wave_item<0, 3>(p, l, P, OACC, OB, cs * 16 + sc, ldsw, ldsv, xbuf, wave);
            asm volatile("s_waitcnt vmcnt(0)" ::: "memory");
            __syncthreads();
            normgate_block(p, l, Pw, OACC, OB, bl * 4096 + sc0 * 256, 0, hp * 2, 2);
        }
        __syncthreads();
    }
}

__device__ __forceinline__ void phase_mix1(const Params& p, int l, int half, bf16_t* P, float* OACC, bf16_t* OB, unsigned char* smem) {
    const int wave = __builtin_amdgcn_readfirstlane(otid() >> 6);
    bf16_t* ldsw = (bf16_t*)(smem + wave * 4096);
    bf16_t* ldsv = (bf16_t*)(smem + 98304 + wave * 4608);
    const int wg = wave & 3;
    for (int b = blockIdx.x; b < 192; b += gridDim.x) {
        const int G = b * 2 + (wave >> 2);
        if (b < 128) {
            const int sc = G & 15, rest = G >> 4, dir = rest & 1, h = (rest >> 1) & 3, bl = rest >> 3;
            const int cs = wg | (dir << 2) | (h << 3) | (bl << 5);
            scan_wave_item<1, 1>(p, l, P, OACC, OB, cs * 16 + sc, ldsw, ldsv, nullptr, 0);
        } else {
            const int G2 = G - 256, sc = G2 & 15, rest = G2 >> 4, dir = rest & 1, hp = (rest >> 1) & 1, bl = rest >> 2;
            const int h = hp * 2 + (wg >> 1), ds = wg & 1;
            const int cs = ds | (dir << 1) | (h << 2) | (bl << 4);
            scan_wave_item<0, 1>(p, l, P, OACC, OB, cs * 16 + sc, ldsw, ldsv, nullptr, 0);
        }
    }
    if (gridDim.x <= 192) { __syncthreads(); na_phase_body(p, l, half, P, smem); }
}

__device__ __forceinline__ float silu_fast(float x) { return x * __builtin_amdgcn_rcpf(1.f + __expf(-x)); }
__device__ __forceinline__ void normgate_block(const Params& p, int l, bf16_t* P, const float* OACC, const bf16_t* OB, int tok0, int br, int h0, int nh) {
    const int tid = otid(), sub = tid & 15, rowi = tid >> 4;
    const float* nw = (br ? p.in[11] : p.in[9]) + l * 128 + sub * 8;
    const f32x4 w0 = *(const f32x4*)nw, w1 = *(const f32x4*)(nw + 4);
    for (int rr = rowi; rr < 256 * nh; rr += 32) {
        const int tok = tok0 + (rr / nh), h = h0 + (rr % nh);
        const size_t oo = (size_t)tok * 1024 + br * 512 + h * 128 + sub * 8;
        f32x4 a0 = *(const f32x4*)(OACC + oo), a1 = *(const f32x4*)(OACC + oo + 4);
        const u32x4 b = *(const u32x4*)(OB + oo);
        bf16_t* gp = P + (size_t)tok * LDP + (br ? C_HG : C_GG) + h * 128 + sub * 8;
        const u32x4 g = *(const u32x4*)gp;
        a0[0] += bflo(b.x); a0[1] += bfhi(b.x); a0[2] += bflo(b.y); a0[3] += bfhi(b.y); a1[0] += bflo(b.z); a1[1] += bfhi(b.z); a1[2] += bflo(b.w); a1[3] += bfhi(b.w);
        float ss = (a0[0] * a0[0] + a0[1] * a0[1]) + (a0[2] * a0[2] + a0[3] * a0[3]) + (a1[0] * a1[0] + a1[1] * a1[1]) + (a1[2] * a1[2] + a1[3] * a1[3]);
        ss += __shfl_xor(ss, 1); ss += __shfl_xor(ss, 2); ss += __shfl_xor(ss, 4); ss += __shfl_xor(ss, 8);
        const float rstd = rsqrtf(ss * (1.f / 128.f) + 1e-6f);
        u32x4 w;
        w.x = cvt_pk_bf16(a0[0] * rstd * w0[0] * silu_fast(bflo(g.x)), a0[1] * rstd * w0[1] * silu_fast(bfhi(g.x)));
        w.y = cvt_pk_bf16(a0[2] * rstd * w0[2] * silu_fast(bflo(g.y)), a0[3] * rstd * w0[3] * silu_fast(bfhi(g.y)));
        w.z = cvt_pk_bf16(a1[0] * rstd * w1[0] * silu_fast(bflo(g.z)), a1[1] * rstd * w1[1] * silu_fast(bfhi(g.z)));
        w.w = cvt_pk_bf16(a1[2] * rstd * w1[2] * silu_fast(bflo(g.w)), a1[3] * rstd * w1[3] * silu_fast(bfhi(g.w)));
        *(u32x4*)gp = w;
    }
}
__device__ __forceinline__ void phase_normgate(const Params& p, int l, bf16_t* P, const float* OACC, const bf16_t* OB) {
    const int tid_ = otid(); const int lane = tid_ & 63, gw = blockIdx.x * 8 + (tid_ >> 6), ngw = gridDim.x * 8;
    for (int ib = gw * 4; ib < MH * 2; ib += ngw * 4) {
        f32x4 o0[4], o1[4]; u32x4 ob[4], gq[4];
#pragma unroll
        for (int q = 0; q < 4; ++q) {
            const int it = ib + q, tok = it >> 1, br = it & 1;
            const float* op = OACC + (size_t)tok * 1024 + br * 512 + lane * 8;
            o0[q] = *(const f32x4*)op; o1[q] = *(const f32x4*)(op + 4);
            ob[q] = *(const u32x4*)(OB + (size_t)tok * 1024 + br * 512 + lane * 8);
            gq[q] = *(const u32x4*)(P + (size_t)tok * LDP + (br ? C_HG : C_GG) + lane * 8);
        }
#pragma unroll
        for (int q = 0; q < 4; ++q) {
            const int it = ib + q, tok = it >> 1, br = it & 1;
            f32x4 a0 = o0[q], a1 = o1[q]; const u32x4 b = ob[q], g = gq[q];
            a0[0] += bflo(b.x); a0[1] += bfhi(b.x); a0[2] += bflo(b.y); a0[3] += bfhi(b.y); a1[0] += bflo(b.z); a1[1] += bfhi(b.z); a1[2] += bflo(b.w); a1[3] += bfhi(b.w);
            float ss = (a0[0] * a0[0] + a0[1] * a0[1]) + (a0[2] * a0[2] + a0[3] * a0[3]) + (a1[0] * a1[0] + a1[1] * a1[1]) + (a1[2] * a1[2] + a1[3] * a1[3]);
            ss += __shfl_xor(ss, 1); ss += __shfl_xor(ss, 2); ss += __shfl_xor(ss, 4); ss += __shfl_xor(ss, 8);
            const float rstd = rsqrtf(ss * (1.f / 128.f) + 1e-6f);
            const float* nw = (br ? p.in[11] : p.in[9]) + l * 128 + (lane & 15) * 8;
            const f32x4 w0 = *(const f32x4*)nw, w1 = *(const f32x4*)(nw + 4);
            u32x4 w;
            w.x = cvt_pk_bf16(a0[0] * rstd * w0[0] * silu_fast(bflo(g.x)), a0[1] * rstd * w0[1] * silu_fast(bfhi(g.x)));
            w.y = cvt_pk_bf16(a0[2] * rstd * w0[2] * silu_fast(bflo(g.y)), a0[3] * rstd * w0[3] * silu_fast(bfhi(g.y)));
            w.z = cvt_pk_bf16(a1[0] * rstd * w1[0] * silu_fast(bflo(g.z)), a1[1] * rstd * w1[1] * silu_fast(bfhi(g.z)));
            w.w = cvt_pk_bf16(a1[2] * rstd * w1[2] * silu_fast(bflo(g.w)), a1[3] * rstd * w1[3] * silu_fast(bfhi(g.w)));
            *(u32x4*)(P + (size_t)tok * LDP + (br ? C_HG : C_GG) + lane * 8) = w;
        }
    }
}

#define XB_TMO      128
#define XB_XCNT(j)  (256  + 64 * (j))
#define XB_XSUB(j)  (1280 + 64 * (j))
#define XB_XGEN(j)  (2304 + 64 * (j))
#define XB_TOP      3328
#define XB_TOPGEN   3392
#define XCD_BAR_WORDS 3456
#define XB_SPIN_CAP (1u << 18)

__device__ __forceinline__ unsigned xb_ld(unsigned* p)              { return __hip_atomic_load(p, __ATOMIC_RELAXED, __HIP_MEMORY_SCOPE_AGENT); }
__device__ __forceinline__ unsigned xb_add(unsigned* p, unsigned v) { return __hip_atomic_fetch_add(p, v, __ATOMIC_RELAXED, __HIP_MEMORY_SCOPE_AGENT); }
__device__ __forceinline__ unsigned xb_xcc_id() { return (unsigned)__builtin_amdgcn_s_getreg((3 << 11) | 20) & 0xFu; }
#define XB_SPIN(cond, bar) do { unsigned _sp = 0; while (cond) { __builtin_amdgcn_s_sleep(1); \
    if ((++_sp & 255u) == 0u) { if (xb_ld(&(bar)[XB_TMO])) break; if (_sp > XB_SPIN_CAP) { atomicAdd(&(bar)[XB_TMO], 1u); break; } } } } while (0)

struct XcdBarrier {
    unsigned* bar; unsigned x;
    volatile LAS unsigned* st;
};

__device__ __forceinline__ XcdBarrier xcd_barrier_post(unsigned* bar, volatile LAS unsigned* st) {
    XcdBarrier b; b.bar = bar; b.x = xb_xcc_id(); b.st = st;
    if (threadIdx.x == 0) (void)xb_add(&bar[XB_XCNT(b.x)], 1u);
    return b;
}
__device__ __forceinline__ void xcd_barrier_complete(unsigned* bar, unsigned x, unsigned& nloc, unsigned& nx) {
    const unsigned G = gridDim.x * gridDim.y * gridDim.z;
    unsigned sum, cnt, mine, sp = 0u;
    for (;;) {
        sum = 0u; cnt = 0u; mine = 0u;
#pragma unroll
        for (unsigned j = 0; j < 16; ++j) { const unsigned c = xb_ld(&bar[XB_XCNT(j)]); sum += c; cnt += (c > 0u) ? 1u : 0u; mine = (j == x) ? c : mine; }
        if (sum == G) break;
        __builtin_amdgcn_s_sleep(1);
        if ((++sp & 255u) == 0u) { if (xb_ld(&bar[XB_TMO])) break; if (sp > XB_SPIN_CAP) { atomicAdd(&bar[XB_TMO], 1u); break; } }
    }
    nloc = mine > 0u ? mine : 1u; nx = cnt > 0u ? cnt : 1u;
}

__device__ __forceinline__ void xcd_barrier(const XcdBarrier& b) {
    asm volatile("s_waitcnt vmcnt(0)" ::: "memory");
    __syncthreads();
    if (threadIdx.x == 0) {
        unsigned* bar = b.bar;
        __builtin_amdgcn_s_waitcnt(0);
        unsigned nloc = b.st[0], nx = b.st[1];
        if (nloc == 0u) { xcd_barrier_complete(bar, b.x, nloc, nx); b.st[0] = nloc; b.st[1] = nx; }
        const unsigned old = xb_add(&bar[XB_XSUB(b.x)], 1u);
        const unsigned gen = old / nloc;
        if (old + 1u == (gen + 1u) * nloc) {
            __builtin_amdgcn_fence(__ATOMIC_RELEASE, "agent");
            asm volatile("s_waitcnt vmcnt(0)" ::: "memory");
            const unsigned og = xb_add(&bar[XB_TOP], 1u);
            const unsigned tg = og / nx;
            if (og + 1u == (tg + 1u) * nx) xb_add(&bar[XB_TOPGEN], 1u);
            else XB_SPIN(xb_ld(&bar[XB_TOPGEN]) == tg, bar);
            __builtin_amdgcn_fence(__ATOMIC_ACQUIRE, "agent");
            xb_add(&bar[XB_XGEN(b.x)], 1u);
            asm volatile("s_waitcnt vmcnt(0)" ::: "memory");
        } else {
            XB_SPIN(xb_ld(&bar[XB_XGEN(b.x)]) == gen, bar);
            __builtin_amdgcn_fence(__ATOMIC_ACQUIRE, "agent");
            asm volatile("s_waitcnt vmcnt(0)" ::: "memory");
        }
    }
    __syncthreads();
}


#define LIB_GRID_SYNC() do { asm volatile("s_waitcnt vmcnt(0) lgkmcnt(0)" ::: "memory"); grid.sync(); \
        asm volatile("buffer_inv sc1\n\ts_waitcnt vmcnt(0)" ::: "memory"); } while (0)
#define GRID_SYNC() xcd_barrier(xb)
__global__ void __launch_bounds__(512, 2) fwd_megakernel(Params p) {
    extern __shared__ __attribute__((aligned(16))) unsigned char smem[];
    cg::grid_group grid = cg::this_grid();
    unsigned char* ws = p.ws;
    const float* mod = (const float*)(ws + WS_MOD);
    bf16_t* Wt_in = (bf16_t*)(ws + WS_WIN); bf16_t* Wt_proj = (bf16_t*)(ws + WS_WPROJ); bf16_t* Wt_out = (bf16_t*)(ws + WS_WOUT);
    bf16_t* Wt_gu = (bf16_t*)(ws + WS_WGU); bf16_t* Wt_dn = (bf16_t*)(ws + WS_WDN);
    bf16_t* H = (bf16_t*)(ws + WS_H); bf16_t* MG = (bf16_t*)(ws + WS_MERGED); float* OACC = (float*)(ws + WS_OACC);
    bf16_t* P = (bf16_t*)(ws + WS_P); bf16_t* GT = (bf16_t*)(ws + WS_GT); bf16_t* H2 = (bf16_t*)(ws + WS_H2); bf16_t* HID = (bf16_t*)(ws + WS_HID);

    volatile LAS unsigned* xb_st = (volatile LAS unsigned*)(smem + 135168 + 64);
    if (otid() == 0) { xb_st[0] = 0u; xb_st[1] = 0u; xb_st[2] = 0u; xb_st[3] = 0u; }
    __syncthreads();
    const XcdBarrier xb = xcd_barrier_post((unsigned*)(ws + WS_BAR), xb_st);
    phase_prep(p, smem);
    __syncthreads();
    phase_convert(p, 0, smem);
    GRID_SYNC();
    for (int l = 0; l < DEPTH; ++l) {
        bf16_t* XB = (bf16_t*)p.out;
        const float* modl = mod + (size_t)l * 4 * 6144;
        if (l) phase_convert(p, l, smem);
        for (int half = 0; half < 2; ++half) {
            if (half == 0) {
                if (l == 0) phase_modnorm<true>(p.in[0], H, 0, MH, p.in[4] + l * 1024, modl + 0, modl + 1024);
                else phase_modnorm<false>(XB, H, 0, MH, p.in[4] + l * 1024, modl + 0, modl + 1024);
                GRID_SYNC();
            }
            run_gemm(smem, H, 1024, Wt_in, MH, NPAD, 1024, EpiP{P, GT});
            if (l == 0 && half == 0) LIB_GRID_SYNC(); else GRID_SYNC();
            phase_mix1(p, l, half, P, OACC, H, smem);
            if (half == 1) phase_combine((bf16_t*)OACC + (size_t)MH * 1024, (bf16_t*)OACC, MG, gridDim.x > 192 ? 192 : 0, gridDim.x > 192 ? (int)gridDim.x - 192 : (int)gridDim.x);
            GRID_SYNC();
            phase_scan3(p, l, half, P, P, OACC, H, smem);
            GRID_SYNC();
            bf16_t* PTa = (bf16_t*)OACC + (size_t)MH * 1024; bf16_t* PTb = (bf16_t*)OACC;
            {
                pg8::Gemm g{P + C_NAQ, LDP, Wt_proj, MH, 1024, 512, (size_t)2560 * 2, (size_t)1024 * 512 * 2};
                pg8::SplitOrder S; S.init2(MH, 1024, (int)gridDim.x, (int)blockIdx.x);
                pg8::gemm_phase<EpiMerge, pg8::SplitOrder>((LAS unsigned char*)smem, g, S, EpiMerge{GT, PTa, half ? H : PTb});
            }
            if (half == 0) { if (l == 0) phase_modnorm<true>(p.in[0], H, MH, MH, p.in[4] + l * 1024, modl + 0, modl + 1024, (int)gridDim.x / 2, (int)gridDim.x - (int)gridDim.x / 2);
                             else phase_modnorm<false>(XB, H, MH, MH, p.in[4] + l * 1024, modl + 0, modl + 1024, (int)gridDim.x / 2, (int)gridDim.x - (int)gridDim.x / 2); }
            GRID_SYNC();
        }
        phase_combine((bf16_t*)OACC + (size_t)MH * 1024, H, MG + (size_t)MH * 1024, 0, (int)gridDim.x);
        GRID_SYNC();
        if (l == 0) run_gemm(smem, MG, 1024, Wt_out, M, 1024, 1024, EpiResid<true>{p.in[0], XB, modl + 2048});
        else run_gemm(smem, MG, 1024, Wt_out, M, 1024, 1024, EpiResid<false>{XB, XB, modl + 2048});
        GRID_SYNC();
        phase_modnorm<false>(XB, H2, 0, M, p.in[16] + l * 1024, modl + 3072, modl + 4096);
        GRID_SYNC();
        run_gemm(smem, H2, 1024, Wt_gu, M, 2 * FF, 1024, EpiGU{HID});
        GRID_SYNC();
        run_gemm(smem, HID, FF, Wt_dn, M, 1024, FF, EpiResid<false>{XB, l + 1 < DEPTH ? XB : H2, modl + 5120});
        GRID_SYNC();
    }
    phase_finalnorm(H2, p.out, p.in[20]);
}

extern "C" void kernel_launch(void* const* d_in, const int* in_sizes, int n_in, void* d_out, int out_size, void* d_ws, size_t ws_size, hipStream_t stream) {
    static int grid_blocks = 0;
    if (grid_blocks == 0) {
        if (n_in != 21 || ws_size < WS_END2) { fprintf(stderr, "kernel_launch: unexpected n_in %d / ws_size %zu (need %zu)\n", n_in, ws_size, (size_t)WS_END2); grid_blocks = -1; return; }
        int dev = 0, cus = 0, per_cu = 0;
        hipGetDevice(&dev);
        hipDeviceGetAttribute(&cus, hipDeviceAttributeMultiprocessorCount, dev);
        if (hipFuncSetAttribute((const void*)fwd_megakernel, hipFuncAttributeMaxDynamicSharedMemorySize, LDS_BYTES) != hipSuccess) fprintf(stderr, "kernel_launch: hipFuncSetAttribute failed\n");
        if (hipOccupancyMaxActiveBlocksPerMultiprocessor(&per_cu, (const void*)fwd_megakernel, 512, LDS_BYTES) != hipSuccess || per_cu < 1) { fprintf(stderr, "kernel_launch: occupancy query says %d\n", per_cu); per_cu = 1; }
        (void)hipGetLastError();
        if (cus <= 0) cus = 256;
        grid_blocks = cus;
    }
    if (grid_blocks < 0) return;
    (void)hipMemsetAsync((char*)d_ws + WS_CTL, 0, 32768, stream);
    Params prm{};
    for (int i = 0; i < 21; ++i) prm.in[i] = (const float*)d_in[i];
    prm.out = (float*)d_out; prm.ws = (unsigned char*)d_ws;
    void* args[] = {&prm};
    hipError_t e = hipLaunchCooperativeKernel((const void*)fwd_megakernel, dim3(grid_blocks), dim3(512), args, LDS_BYTES, stream);
    if (e != hipSuccess) fprintf(stderr, "cooperative launch failed: %s (grid %d)\n", hipGetErrorString(e), grid_blocks);
}
```

```cpp
#include <hip/hip_runtime.h>
#include <hip/hip_cooperative_groups.h>
#include <cstdio>
namespace cg = cooperative_groups;

#define LAS __attribute__((address_space(3)))
typedef unsigned short bf16_t;
typedef short bf16x8 __attribute__((ext_vector_type(8)));
typedef float f32x4 __attribute__((ext_vector_type(4)));
typedef unsigned u32x4 __attribute__((ext_vector_type(4)));
typedef unsigned u32x2 __attribute__((ext_vector_type(2)));

constexpr int D = 1024, T = 4096, NBATCH = 4, M = NBATCH * T, MH = M / 2, DEPTH = 2;
constexpr int PROJW = 8736, LDP = 5664, NPAD = 8960, FF = 2816;
constexpr int C_NAQ = 0, C_NAK = 512, C_NAV = 1024, C_GQ = 1536, C_GK = 1792, C_GV = 2048, C_GG = 2560, C_HQ = 3072, C_HF = 3584, C_HI = 4608, C_HG = 5120, C_LR = 5632;
constexpr int LDS_BYTES = 135168 + 2048;

constexpr size_t WS_CTL = 0;
constexpr size_t WS_BAR = 1024;
constexpr size_t WS_MOD = 32768;
constexpr size_t WS_LB = WS_MOD + 2 * 4 * 6144 * 4;
constexpr size_t WS_WIN = WS_LB + 2 * 1024 * 4;
constexpr size_t WS_WPROJ = WS_WIN + (size_t)NPAD * 1024 * 2;
constexpr size_t WS_WOUT = WS_WPROJ + (size_t)3 * 1024 * 512 * 2;
constexpr size_t WS_WGU = WS_WOUT + (size_t)1024 * 1024 * 2;
constexpr size_t WS_WDN = WS_WGU + (size_t)5632 * 1024 * 2;
constexpr size_t WS_H = WS_WDN + (size_t)1024 * 2816 * 2;
constexpr size_t WS_MERGED = WS_H + (size_t)MH * 1024 * 2;
constexpr size_t WS_OACC = WS_MERGED + (size_t)MH * 1024 * 2;
constexpr size_t WS_P = WS_OACC + (size_t)MH * 1024 * 4;
constexpr size_t WS_GT = WS_P + (size_t)MH * LDP * 2;
constexpr size_t WS_H2 = WS_P;
constexpr size_t WS_HID = WS_P + (size_t)M * 1024 * 2;
constexpr size_t WS_END = WS_GT + (size_t)MH * 3072 * 2;
static_assert(WS_HID + (size_t)M * FF * 2 <= WS_END, "ffn scratch must fit in the P region");
constexpr size_t WS_SLOC = WS_END;
constexpr size_t WS_LA = WS_SLOC + (size_t)1536 * 8192;
constexpr size_t WS_END2 = WS_LA + (size_t)1536 * 512;
static_assert(WS_END2 <= (size_t)256 * 1024 * 1024, "workspace must fit the guaranteed 256 MiB");

struct Params {
    const float* in[21];
    float* out;
    unsigned char* ws;
};

__device__ __forceinline__ float bf2f(unsigned short b) { return __uint_as_float(((unsigned)b) << 16); }
__device__ __forceinline__ float bflo(unsigned w) { return __uint_as_float(w << 16); }
__device__ __forceinline__ float bfhi(unsigned w) { return __uint_as_float(w & 0xffff0000u); }
typedef float f32x2_t __attribute__((ext_vector_type(2)));
typedef __bf16 bf16x2_t __attribute__((ext_vector_type(2)));
__device__ __forceinline__ unsigned cvt_pk_bf16(float lo, float hi) { f32x2_t f = {lo, hi}; bf16x2_t v = __builtin_convertvector(f, bf16x2_t); return __builtin_bit_cast(unsigned, v); }
__device__ __forceinline__ float sigmoidf_(float x) { return __builtin_amdgcn_rcpf(1.f + __expf(-x)); }
__device__ __forceinline__ float siluf_(float x) { return x * __builtin_amdgcn_rcpf(1.f + __expf(-x)); }
__device__ __forceinline__ int otid() { int t = threadIdx.x; asm volatile("" : "+v"(t)); return t; }
__device__ __forceinline__ float wave_sum(float v) {
#pragma unroll
    for (int o = 1; o < 64; o <<= 1) v += __shfl_xor(v, o);
    return v;
}

namespace pg8 {
constexpr int BM = 256, BK = 64, HALF = 128, HTB = HALF * BK * 2, STAGE_BYTES = 8 * HTB, NXCD = 8, WGM = 4;
__device__ __forceinline__ int lds_byte(int r, int c) { const int st = (r >> 4) * 2 + (c >> 5), rr = r & 15, cc = c & 31, ob = rr * 64 + cc * 2; return st * 1024 + (ob ^ (((ob >> 9) & 1) << 5)); }
__device__ __forceinline__ void stage_rc(int b, int& R, int& C) { const int st = b / 1024, sb = b % 1024, swz = sb ^ (((sb >> 9) & 1) << 5); R = (st >> 1) * 16 + swz / 64; C = (st & 1) * 32 + (swz % 64) / 2; }
__device__ __forceinline__ int perm32(int rho) { const int n = rho >> 4, i = rho & 15; return 8 * (i >> 2) + 4 * n + (i & 3); }
struct Unit { int pm, pn, b; };
struct Gemm { const bf16_t* A; int lda; const bf16_t* Bt; int M, N, K; size_t astep, bstep; };
struct StaticOrder {
    int nM, nN, nwg, G, c;
    __device__ void init(int M_, int N_, int G_, int c_) { nM = M_ / BM; nN = N_ / BM; nwg = nM * nN; G = G_; c = c_; }
    __device__ bool next(int i, Unit& u) const {
        const long L = (long)i * G + c; if (L >= nwg) return false;
        int wgid = (int)L; { const int q = nwg / NXCD, r = nwg % NXCD, xcd = wgid % NXCD, off = wgid / NXCD; wgid = (xcd < r ? xcd * (q + 1) : r * (q + 1) + (xcd - r) * q) + off; }
        const int nig = WGM * nN, gid = wgid / nig, fm = gid * WGM, gsz = (nM - fm) < WGM ? (nM - fm) : WGM;
        u.pm = fm + ((wgid % nig) % gsz); u.pn = (wgid % nig) / gsz; u.b = 0; return true;
    }
};
struct SplitOrder : StaticOrder {
    int side, half_g;
    __device__ void init2(int M_, int N_, int G_, int c_) { half_g = G_ / 2; side = c_ >= half_g ? 1 : 0; init(M_, N_, half_g, c_ - side * half_g); }
    __device__ bool next(int i, Unit& u) const {
        const int nb = side ? 1 : 2, q = i / nb; if (!StaticOrder::next(q, u)) return false; u.b = side ? 2 : (i - q * nb); return true; }
};

template <class Epi, class Sched>
__device__ __forceinline__ void gemm_phase(LAS unsigned char* lds, const Gemm g, const Sched& S, const Epi& E) {
    const int tid = otid(), wid = __builtin_amdgcn_readfirstlane(tid >> 6), lane = tid & 63, wr = wid >> 2, wc = wid & 3, fr = lane & 15, fq = lane >> 4;
    const int K = g.K, nt = K / BK, lda = g.lda;
    unsigned voffA[2], voffB[2];
#pragma unroll
    for (int i = 0; i < 2; ++i) { int R, C; stage_rc(tid * 16 + i * 8192, R, C); const int Rb = Epi::PERM ? ((R & ~31) + perm32(R & 31)) : R;
        voffA[i] = (unsigned)(R * lda + C) * 2u; voffB[i] = (unsigned)(Rb * K + C) * 2u; }
    const size_t kstep = (size_t)(BK * 2);
    const size_t hstepA = (size_t)HALF * lda * 2, hstepB = (size_t)HALF * K * 2;
    const size_t tstepA = 2 * hstepA, tstepB = 2 * hstepB;
    const unsigned ldsw = (unsigned)wid * 1024u;
    const int aoff = lds_byte(wr * 64 + fr, fq * 8), boff = lds_byte(wc * 32 + fr, fq * 8);
#define PG8_SA(b, h) (((b) * 2 + (h)) * HTB)
#define PG8_SB(b, h) ((4 + (b) * 2 + (h)) * HTB)
#define PG8_STAGE(bufoff, gbase, voff) do { _Pragma("unroll") for (int _i = 0; _i < 2; ++_i) \
        __builtin_amdgcn_global_load_lds((const unsigned*)((const char*)(gbase) + (voff)[_i]), (LAS unsigned*)(lds + (bufoff) + ldsw + _i * 8192), 16, 0, 0); } while (0)
#define PG8_LDA(dst, b, h) do { _Pragma("unroll") for (int m = 0; m < 4; ++m) _Pragma("unroll") for (int k = 0; k < 2; ++k) dst[m][k] = *(const LAS bf16x8*)(lds + PG8_SA(b, h) + aoff + m * 2048 + k * 1024); } while (0)
#define PG8_LDB(dst, b, h) do { _Pragma("unroll") for (int n = 0; n < 2; ++n) _Pragma("unroll") for (int k = 0; k < 2; ++k) dst[n][k] = *(const LAS bf16x8*)(lds + PG8_SB(b, h) + boff + n * 2048 + k * 1024); } while (0)
#define PG8_MMA(ai, bj, At, Bt) do { __builtin_amdgcn_s_setprio(1); _Pragma("unroll") for (int m = 0; m < 4; ++m) _Pragma("unroll") for (int n = 0; n < 2; ++n) _Pragma("unroll") for (int k = 0; k < 2; ++k) \
        acc[ai][bj][m][n] = __builtin_amdgcn_mfma_f32_16x16x32_bf16(Bt[n][k], At[m][k], acc[ai][bj][m][n], 0, 0, 0); __builtin_amdgcn_s_setprio(0); } while (0)
#define PG8_WAIT_V(n) asm volatile("s_waitcnt vmcnt(" #n ")" ::: "memory")
#define PG8_WAIT_L(n) asm volatile("s_waitcnt lgkmcnt(" #n ")" ::: "memory")
#define PG8_BAR __builtin_amdgcn_s_barrier()
#define PG8_SCHED __builtin_amdgcn_sched_barrier(0)
    Unit cur, nxt; int ui = 0;
    if (!S.next(0, cur)) return;
    f32x4 acc[2][2][4][2];
#pragma unroll
    for (int a = 0; a < 2; ++a)
#pragma unroll
        for (int b = 0; b < 2; ++b)
#pragma unroll
            for (int m = 0; m < 4; ++m)
#pragma unroll
                for (int n = 0; n < 2; ++n) acc[a][b][m][n] = (f32x4){0.f, 0.f, 0.f, 0.f};
    bf16x8 At[4][2], B0[2][2], B1[2][2];
    const char* cA = (const char*)g.A + (size_t)cur.pm * tstepA + cur.b * g.astep; const char* cB = (const char*)g.Bt + (size_t)cur.pn * tstepB + cur.b * g.bstep;
    PG8_STAGE(PG8_SB(0, 0), cB, voffB); PG8_STAGE(PG8_SA(0, 0), cA, voffA); PG8_STAGE(PG8_SB(0, 1), cB + hstepB, voffB); PG8_STAGE(PG8_SA(0, 1), cA + hstepA, voffA);
    if (wr == 1) PG8_BAR;
    PG8_WAIT_V(4); PG8_BAR;
    PG8_STAGE(PG8_SB(1, 0), cB + kstep, voffB); PG8_STAGE(PG8_SA(1, 0), cA + kstep, voffA); PG8_STAGE(PG8_SB(1, 1), cB + hstepB + kstep, voffB);
    PG8_WAIT_V(6); PG8_BAR;
    for (;;) {
        const bool has_next = S.next(ui + 1, nxt);
        const char* nA = has_next ? (const char*)g.A + (size_t)nxt.pm * tstepA + nxt.b * g.astep : cA; const char* nB = has_next ? (const char*)g.Bt + (size_t)nxt.pn * tstepB + nxt.b * g.bstep : cB;
        for (int t = 0; t < nt; t += 2) {
            const bool last = (t == nt - 2);
            const char* a1 = cA + (size_t)(t + 1) * kstep;
            const char* a2 = last ? nA : cA + (size_t)(t + 2) * kstep; const char* b2 = last ? nB : cB + (size_t)(t + 2) * kstep;
            const char* a3 = a2 + kstep; const char* b3 = b2 + kstep;
            PG8_LDB(B0, 0, 0); PG8_SCHED; PG8_LDA(At, 0, 0); PG8_STAGE(PG8_SA(1, 1), a1 + hstepA, voffA);
            PG8_WAIT_L(8); PG8_BAR; PG8_WAIT_L(0); PG8_MMA(0, 0, At, B0); PG8_BAR; PG8_SCHED;
            PG8_LDB(B1, 0, 1); PG8_STAGE(PG8_SB(0, 0), b2, voffB);
            PG8_BAR; PG8_WAIT_L(0); PG8_MMA(0, 1, At, B1); PG8_BAR;
            PG8_LDA(At, 0, 1); PG8_STAGE(PG8_SA(0, 0), a2, voffA);
            PG8_BAR; PG8_WAIT_L(0); PG8_MMA(1, 0, At, B0); PG8_BAR; PG8_SCHED;
            PG8_STAGE(PG8_SB(0, 1), b2 + hstepB, voffB);
            PG8_WAIT_V(6); PG8_BAR; PG8_MMA(1, 1, At, B1); PG8_BAR;
            PG8_LDB(B0, 1, 0); PG8_SCHED; PG8_LDA(At, 1, 0); PG8_STAGE(PG8_SA(0, 1), a2 + hstepA, voffA);
            PG8_WAIT_L(8); PG8_BAR; PG8_WAIT_L(0); PG8_MMA(0, 0, At, B0); PG8_BAR; PG8_SCHED;
            PG8_LDB(B1, 1, 1); PG8_STAGE(PG8_SB(1, 0), b3, voffB);
            PG8_BAR; PG8_WAIT_L(0); PG8_MMA(0, 1, At, B1); PG8_BAR;
            PG8_LDA(At, 1, 1); PG8_STAGE(PG8_SA(1, 0), a3, voffA);
            PG8_BAR; PG8_WAIT_L(0); PG8_MMA(1, 0, At, B0); PG8_BAR; PG8_SCHED;
            PG8_STAGE(PG8_SB(1, 1), b3 + hstepB, voffB);
            PG8_WAIT_V(6); PG8_BAR; PG8_MMA(1, 1, At, B1); PG8_BAR;
        }
        E(acc, cur, wr, wc, fr, fq);
        if (!has_next) break;
#pragma unroll
        for (int a = 0; a < 2; ++a)
#pragma unroll
            for (int b = 0; b < 2; ++b)
#pragma unroll
                for (int m = 0; m < 4; ++m)
#pragma unroll
                    for (int n = 0; n < 2; ++n) acc[a][b][m][n] = (f32x4){0.f, 0.f, 0.f, 0.f};
        cur = nxt; cA = nA; cB = nB; ++ui;
    }
    PG8_WAIT_V(0);
    if (wr == 0) PG8_BAR;
    PG8_BAR;
#undef PG8_SA
#undef PG8_SB
#undef PG8_STAGE
#undef PG8_LDA
#undef PG8_LDB
#undef PG8_MMA
#undef PG8_WAIT_V
#undef PG8_WAIT_L
#undef PG8_BAR
#undef PG8_SCHED
}
}
using pg8::Unit;

struct EpiP {
    static constexpr bool PERM = true;
    bf16_t* P; bf16_t* GT;
    __device__ __forceinline__ void operator()(const f32x4 (&acc)[2][2][4][2], const Unit& u, int wr, int wc, int fr, int fq) const {
        const int row0 = u.pm * 256 + wr * 64 + fr;
        if (u.pn >= 22 && u.pn < 34) {
            u32x4* gt = (u32x4*)GT + ((size_t)(u.pm * 12 + (u.pn - 22)) * 16) * 512 + ((wr * 4 + wc) * 64 + fq * 16 + fr);
#pragma unroll
            for (int bj = 0; bj < 2; ++bj)
#pragma unroll
                for (int ai = 0; ai < 2; ++ai)
#pragma unroll
                    for (int m = 0; m < 4; ++m) {
                        const f32x4 v0 = acc[ai][bj][m][0], v1 = acc[ai][bj][m][1];
                        u32x4 w; w.x = cvt_pk_bf16(sigmoidf_(v0[0]), sigmoidf_(v0[1])); w.y = cvt_pk_bf16(sigmoidf_(v0[2]), sigmoidf_(v0[3]));
                        w.z = cvt_pk_bf16(sigmoidf_(v1[0]), sigmoidf_(v1[1])); w.w = cvt_pk_bf16(sigmoidf_(v1[2]), sigmoidf_(v1[3]));
                        gt[(size_t)((bj * 2 + ai) * 4 + m) * 512] = w;
                    }
            return;
        }
        const bool sig = false;
#pragma unroll
        for (int bj = 0; bj < 2; ++bj) {
            const int c0 = (u.pn < 22 ? u.pn * 256 : C_LR) + bj * 128 + wc * 32 + 8 * fq;
            if (u.pn >= 22 && (bj * 128 + wc * 32 + 8 * fq) >= 32) continue;
#pragma unroll
            for (int ai = 0; ai < 2; ++ai)
#pragma unroll
                for (int m = 0; m < 4; ++m) {
                    f32x4 v0 = acc[ai][bj][m][0], v1 = acc[ai][bj][m][1];
                    if (sig) {
#pragma unroll
                        for (int j = 0; j < 4; ++j) { v0[j] = sigmoidf_(v0[j]); v1[j] = sigmoidf_(v1[j]); }
                    }
                    u32x4 w; w.x = cvt_pk_bf16(v0[0], v0[1]); w.y = cvt_pk_bf16(v0[2], v0[3]); w.z = cvt_pk_bf16(v1[0], v1[1]); w.w = cvt_pk_bf16(v1[2], v1[3]);
                    *(u32x4*)(P + (size_t)(row0 + ai * 128 + m * 16) * LDP + c0) = w;
                }
        }
    }
};
struct EpiMerge {
    static constexpr bool PERM = true;
    const bf16_t* GT; bf16_t* PT; bf16_t* PT2;
    __device__ __forceinline__ void operator()(const f32x4 (&acc)[2][2][4][2], const Unit& u, int wr, int wc, int fr, int fq) const {
        const int b = u.b, tslot = (wr * 4 + wc) * 64 + fq * 16 + fr;
        const u32x4* gt = (const u32x4*)GT + ((size_t)(u.pm * 12 + b * 4 + u.pn) * 16) * 512 + tslot;
        u32x4* pt = (u32x4*)(b == 2 ? PT2 : PT) + ((size_t)(u.pm * 4 + u.pn) * 16) * 512 + tslot;
#pragma unroll
        for (int bj = 0; bj < 2; ++bj)
#pragma unroll
            for (int ai = 0; ai < 2; ++ai)
#pragma unroll
                for (int m = 0; m < 4; ++m) {
                    const int idx = (bj * 2 + ai) * 4 + m;
                    const u32x4 g = gt[(size_t)idx * 512];
                    u32x4 pv = (u32x4){0u, 0u, 0u, 0u};
                    if (b == 1) pv = pt[(size_t)idx * 512];
                    const f32x4 v0 = acc[ai][bj][m][0], v1 = acc[ai][bj][m][1];
                    u32x4 w;
                    w.x = cvt_pk_bf16(bflo(pv.x) + bflo(g.x) * v0[0], bfhi(pv.x) + bfhi(g.x) * v0[1]);
                    w.y = cvt_pk_bf16(bflo(pv.y) + bflo(g.y) * v0[2], bfhi(pv.y) + bfhi(g.y) * v0[3]);
                    w.z = cvt_pk_bf16(bflo(pv.z) + bflo(g.z) * v1[0], bfhi(pv.z) + bfhi(g.z) * v1[1]);
                    w.w = cvt_pk_bf16(bflo(pv.w) + bflo(g.w) * v1[2], bfhi(pv.w) + bfhi(g.w) * v1[3]);
                    pt[(size_t)idx * 512] = w;
                }
    }
};
__device__ __forceinline__ void phase_combine(const bf16_t* PT, const bf16_t* PT2, bf16_t* Mg, int b0, int nb) {
    const int tid = otid();
    if ((int)blockIdx.x < b0 || (int)blockIdx.x >= b0 + nb) return;
    for (int e = ((int)blockIdx.x - b0) * 512 + tid; e < 128 * 16 * 512; e += nb * 512) {
        const u32x4 a = ((const u32x4*)PT)[e], c = ((const u32x4*)PT2)[e];
        const int tslot = e & 511, idx = (e >> 9) & 15, tile = e >> 13, pm = tile >> 2, pn = tile & 3;
        const int wv = tslot >> 6, ln = tslot & 63, wr = wv >> 2, wc = wv & 3, fq = ln >> 4, fr = ln & 15;
        const int bj = idx >> 3, ai = (idx >> 2) & 1, m = idx & 3;
        const int row = pm * 256 + ai * 128 + wr * 64 + m * 16 + fr, c0 = pn * 256 + bj * 128 + wc * 32 + 8 * fq;
        u32x4 w;
        w.x = cvt_pk_bf16(bflo(a.x) + bflo(c.x), bfhi(a.x) + bfhi(c.x)); w.y = cvt_pk_bf16(bflo(a.y) + bflo(c.y), bfhi(a.y) + bfhi(c.y));
        w.z = cvt_pk_bf16(bflo(a.z) + bflo(c.z), bfhi(a.z) + bfhi(c.z)); w.w = cvt_pk_bf16(bflo(a.w) + bflo(c.w), bfhi(a.w) + bfhi(c.w));
        *(u32x4*)(Mg + (size_t)row * 1024 + c0) = w;
    }
}
template <bool IN_F32>
struct EpiResid {
    static constexpr bool PERM = false;
    const void* xin; bf16_t* xout; const float* gate;
    __device__ __forceinline__ void operator()(const f32x4 (&acc)[2][2][4][2], const Unit& u, int wr, int wc, int fr, int fq) const {
        const int row0 = u.pm * 256 + wr * 64 + fr, col0 = u.pn * 256 + wc * 32 + 4 * fq;
        const int bidx = (u.pm * 256) >> 12;
        f32x4 gv[2][2];
#pragma unroll
        for (int bj = 0; bj < 2; ++bj)
#pragma unroll
            for (int n = 0; n < 2; ++n) gv[bj][n] = *(const f32x4*)(gate + bidx * 6144 + col0 + bj * 128 + n * 16);
#pragma unroll
        for (int ai = 0; ai < 2; ++ai)
#pragma unroll
            for (int m = 0; m < 4; ++m) {
                const size_t ro = (size_t)(row0 + ai * 128 + m * 16) * 1024 + col0;
#pragma unroll
                for (int bj = 0; bj < 2; ++bj)
#pragma unroll
                    for (int n = 0; n < 2; ++n) {
                        f32x4 xv;
                        if (IN_F32) xv = *(const f32x4*)((const float*)xin + ro + bj * 128 + n * 16);
                        else { const u32x2 xb = *(const u32x2*)((const bf16_t*)xin + ro + bj * 128 + n * 16); xv = (f32x4){bflo(xb.x), bfhi(xb.x), bflo(xb.y), bfhi(xb.y)}; }
                        const f32x4 y = xv + gv[bj][n] * acc[ai][bj][m][n];
                        u32x2 o; o.x = cvt_pk_bf16(y[0], y[1]); o.y = cvt_pk_bf16(y[2], y[3]);
                        *(u32x2*)(xout + ro + bj * 128 + n * 16) = o;
                    }
            }
    }
};
struct EpiGU {
    static constexpr bool PERM = false;
    bf16_t* Hid;
    __device__ __forceinline__ void operator()(const f32x4 (&acc)[2][2][4][2], const Unit& u, int wr, int wc, int fr, int fq) const {
        const int row0 = u.pm * 256 + wr * 64 + fr, hc0 = u.pn * 128 + wc * 16 + 4 * fq;
#pragma unroll
        for (int ai = 0; ai < 2; ++ai)
#pragma unroll
            for (int m = 0; m < 4; ++m)
#pragma unroll
                for (int bj = 0; bj < 2; ++bj) {
                    const f32x4 gt = acc[ai][bj][m][0], up = acc[ai][bj][m][1];
                    u32x2 w; w.x = cvt_pk_bf16(siluf_(gt[0]) * up[0], siluf_(gt[1]) * up[1]); w.y = cvt_pk_bf16(siluf_(gt[2]) * up[2], siluf_(gt[3]) * up[3]);
                    *(u32x2*)(Hid + (size_t)(row0 + ai * 128 + m * 16) * FF + hc0 + bj * 64) = w;
                }
    }
};

template <class Epi>
__device__ __forceinline__ void run_gemm(unsigned char* smem, const bf16_t* A, int lda, const bf16_t* Bt, int Mrows, int N, int K, const Epi& E) {
    pg8::Gemm g{A, lda, Bt, Mrows, N, K, 0, 0};
    pg8::StaticOrder S; S.init(Mrows, N, (int)gridDim.x, (int)blockIdx.x);
    pg8::gemm_phase<Epi, pg8::StaticOrder>((LAS unsigned char*)smem, g, S, E);
}

__device__ __forceinline__ void phase_prep(const Params& p, unsigned char* smem) {
    const int tid = otid();
    float* cact = (float*)smem;
    float* red = cact + 4096;
    for (int i = tid; i < 4096; i += 512) cact[i] = siluf_(p.in[1][i]);
    __syncthreads();
    float* mod = (float*)(p.ws + WS_MOD);
    for (int item = blockIdx.x; item < 192; item += gridDim.x) {
        const int l = item / 96, cb = item % 96, col = cb * 64 + (tid & 63), kg = tid >> 6;
        const float* W = p.in[2] + (size_t)l * 1024 * 6144 + col;
        float a0 = 0.f, a1 = 0.f, a2 = 0.f, a3 = 0.f;
#pragma unroll 16
        for (int k = kg * 128; k < kg * 128 + 128; ++k) {
            const float w = __builtin_nontemporal_load(W + (size_t)k * 6144);
            a0 += cact[k] * w; a1 += cact[1024 + k] * w; a2 += cact[2048 + k] * w; a3 += cact[3072 + k] * w;
        }
        red[(kg * 4 + 0) * 64 + (tid & 63)] = a0; red[(kg * 4 + 1) * 64 + (tid & 63)] = a1;
        red[(kg * 4 + 2) * 64 + (tid & 63)] = a2; red[(kg * 4 + 3) * 64 + (tid & 63)] = a3;
        __syncthreads();
        if (tid < 256) {
            const int b = tid >> 6, c = tid & 63;
            float s = p.in[3][l * 6144 + cb * 64 + c];
#pragma unroll
            for (int g = 0; g < 8; ++g) s += red[(g * 4 + b) * 64 + c];
            mod[(l * 4 + b) * 6144 + cb * 64 + c] = s;
        }
        __syncthreads();
    }
    float* lb = (float*)(p.ws + WS_LB);
    for (int j = blockIdx.x * 512 + tid; j < 1024; j += gridDim.x * 512) {
        const float l0 = p.in[10][j], l1 = p.in[10][1024 + j];
        const float mx = fmaxf(l0, l1), e0 = __expf(l0 - mx), e1 = __expf(l1 - mx), inv = 1.f / (e0 + e1);
        const float p0 = e0 * inv, p1 = e1 * inv;
        lb[j] = fminf(fmaxf(p0 - p0, 0.f), 1.f);
        lb[1024 + j] = fminf(fmaxf((p0 + p1) - p0, 0.f), 1.f);
    }
}

__device__ __forceinline__ void convert_item(const Params& p, int l, int mat, int tileidx, float* scr, int lane) {
    int K; bf16_t* dst;
    switch (mat) {
        case 0: K = 1024; dst = (bf16_t*)(p.ws + WS_WIN); break;
        case 1: case 2: case 3: K = 512; dst = (bf16_t*)(p.ws + WS_WPROJ) + (size_t)(mat - 1) * 1024 * 512; break;
        case 4: K = 1024; dst = (bf16_t*)(p.ws + WS_WOUT); break;
        case 5: K = 1024; dst = (bf16_t*)(p.ws + WS_WGU); break;
        default: K = 2816; dst = (bf16_t*)(p.ws + WS_WDN); break;
    }
    const int nkt = K / 64, n0 = (tileidx / nkt) * 32, k0 = (tileidx % nkt) * 64;
    {
        const int n = n0 + (lane & 31);
        const float* src = nullptr; int ld = 0;
        switch (mat) {
            case 0: { int col = -1; if (n < 3072) col = n; else if (n < 8704) col = n + 32; else if (n < 8736) col = n - 8704 + 3072;
                      if (col >= 0) src = p.in[5] + (size_t)l * 1024 * 8736 + col; ld = 8736; break; }
            case 1: src = p.in[12] + (size_t)l * 512 * 1024 + n; ld = 1024; break;
            case 2: src = p.in[13] + (size_t)l * 512 * 1024 + n; ld = 1024; break;
            case 3: src = p.in[14] + (size_t)l * 512 * 1024 + n; ld = 1024; break;
            case 4: src = p.in[15] + (size_t)l * 1024 * 1024 + n; ld = 1024; break;
            case 5: { const int G = n >> 5, r = n & 31; src = (r < 16 ? p.in[17] : p.in[18]) + (size_t)l * 1024 * 2816 + 16 * G + (r & 15); ld = 2816; break; }
            default: src = p.in[19] + (size_t)l * 2816 * 1024 + n; ld = 1024; break;
        }
        float v[32];
#pragma unroll
        for (int i = 0; i < 32; ++i) { const int kk = 2 * i + (lane >> 5); v[i] = src ? __builtin_nontemporal_load(src + (size_t)(k0 + kk) * ld) : 0.f; }
#pragma unroll
        for (int i = 0; i < 32; ++i) { const int kk = 2 * i + (lane >> 5); scr[kk * 33 + (lane & 31)] = v[i]; }
    }
    asm volatile("s_waitcnt lgkmcnt(0)" ::: "memory"); __builtin_amdgcn_wave_barrier();
    {
        const int c = lane & 7;
#pragma unroll
        for (int j = 0; j < 4; ++j) {
            const int n = (lane >> 3) + 8 * j; const float* s = scr + (8 * c) * 33 + n;
            u32x4 o; o.x = cvt_pk_bf16(s[0], s[33]); o.y = cvt_pk_bf16(s[2 * 33], s[3 * 33]); o.z = cvt_pk_bf16(s[4 * 33], s[5 * 33]); o.w = cvt_pk_bf16(s[6 * 33], s[7 * 33]);
            *(u32x4*)(dst + (size_t)(n0 + n) * K + k0 + 8 * c) = o;
        }
    }
    asm volatile("s_waitcnt lgkmcnt(0)" ::: "memory"); __builtin_amdgcn_wave_barrier();
}
__device__ __forceinline__ void phase_convert(const Params& p, int l, unsigned char* smem) {
    const int tid = otid(), wave = __builtin_amdgcn_readfirstlane(tid >> 6), lane = tid & 63;
    float* scr = (float*)(smem + 32768 + wave * 8704);
    constexpr int I0 = 280 * 16, I1 = 32 * 8, I4 = 32 * 16, I5 = 176 * 16, I6 = 32 * 44;
    constexpr int NIT = I0 + 3 * I1 + I4 + I5 + I6;
    for (int it = blockIdx.x * 8 + wave; it < NIT; it += gridDim.x * 8) {
        int r = it;
        if (r < I0) { convert_item(p, l, 0, r, scr, lane); continue; } r -= I0;
        if (r < I1) { convert_item(p, l, 1, r, scr, lane); continue; } r -= I1;
        if (r < I1) { convert_item(p, l, 2, r, scr, lane); continue; } r -= I1;
        if (r < I1) { convert_item(p, l, 3, r, scr, lane); continue; } r -= I1;
        if (r < I4) { convert_item(p, l, 4, r, scr, lane); continue; } r -= I4;
        if (r < I5) { convert_item(p, l, 5, r, scr, lane); continue; } r -= I5;
        convert_item(p, l, 6, r, scr, lane);
    }
}

template <bool IN_F32>
__device__ __forceinline__ void load_row16(const void* x, size_t row, int lane, f32x4 (&v)[4]) {
    if (IN_F32) {
        const f32x4* xr = (const f32x4*)((const float*)x + row * 1024) + lane;
#pragma unroll
        for (int j = 0; j < 4; ++j) v[j] = xr[64 * j];
    } else {
        const u32x2* xr = (const u32x2*)((const bf16_t*)x + row * 1024) + lane;
#pragma unroll
        for (int j = 0; j < 4; ++j) { const u32x2 w = xr[64 * j]; v[j] = (f32x4){bflo(w.x), bfhi(w.x), bflo(w.y), bfhi(w.y)}; }
    }
}
template <bool IN_F32>
__device__ __forceinline__ void phase_modnorm(const void* x, bf16_t* dst, int row0, int nrows, const float* nw, const float* shift, const float* scale, int b0 = 0, int nb = 0) {
    if (nb == 0) nb = (int)gridDim.x;
    if ((int)blockIdx.x < b0 || (int)blockIdx.x >= b0 + nb) return;
    const int tid_ = otid(); const int lane = tid_ & 63, gw = ((int)blockIdx.x - b0) * 8 + (tid_ >> 6), ngw = nb * 8;
    for (int rb = gw * 4; rb < nrows; rb += ngw * 4) {
        f32x4 v[4][4];
#pragma unroll
        for (int q = 0; q < 4; ++q) load_row16<IN_F32>(x, (size_t)(row0 + rb + q), lane, v[q]);
#pragma unroll
        for (int q = 0; q < 4; ++q) {
            const int r = rb + q, b = (row0 + r) >> 12;
            float ss = 0.f;
#pragma unroll
            for (int j = 0; j < 4; ++j) ss += (v[q][j][0] * v[q][j][0] + v[q][j][1] * v[q][j][1]) + (v[q][j][2] * v[q][j][2] + v[q][j][3] * v[q][j][3]);
            const float rstd = rsqrtf(wave_sum(ss) * (1.f / 1024.f) + 1e-6f);
#pragma unroll
            for (int j = 0; j < 4; ++j) {
                const int c = lane * 4 + 256 * j;
                const f32x4 w4 = *(const f32x4*)(nw + c), sc = *(const f32x4*)(scale + b * 6144 + c), sh = *(const f32x4*)(shift + b * 6144 + c);
                const f32x4 y = v[q][j] * rstd * w4 * (sc + 1.f) + sh;
                u32x2 o; o.x = cvt_pk_bf16(y[0], y[1]); o.y = cvt_pk_bf16(y[2], y[3]);
                *(u32x2*)(dst + (size_t)r * 1024 + c) = o;
            }
        }
    }
}
__device__ __forceinline__ void phase_finalnorm(const bf16_t* x, float* out, const float* nw) {
    const int tid_ = otid(); const int lane = tid_ & 63, gw = blockIdx.x * 8 + (tid_ >> 6), ngw = gridDim.x * 8;
    for (int rb = gw * 4; rb < M; rb += ngw * 4) {
        f32x4 v[4][4];
#pragma unroll
        for (int q = 0; q < 4; ++q) load_row16<false>(x, (size_t)(rb + q), lane, v[q]);
#pragma unroll
        for (int q = 0; q < 4; ++q) {
            f32x4* xr = (f32x4*)(out + (size_t)(rb + q) * 1024) + lane;
            float ss = 0.f;
#pragma unroll
            for (int j = 0; j < 4; ++j) ss += (v[q][j][0] * v[q][j][0] + v[q][j][1] * v[q][j][1]) + (v[q][j][2] * v[q][j][2] + v[q][j][3] * v[q][j][3]);
            const float rstd = rsqrtf(wave_sum(ss) * (1.f / 1024.f) + 1e-6f);
#pragma unroll
            for (int j = 0; j < 4; ++j) { const f32x4 w4 = *(const f32x4*)(nw + lane * 4 + 256 * j); xr[64 * j] = v[q][j] * rstd * w4; }
        }
    }
}
__device__ __forceinline__ void phase_zero(float* buf, size_t n4) {
    f32x4* b4 = (f32x4*)buf;
    const int tid_ = otid();
    for (size_t i = (size_t)blockIdx.x * 512 + tid_; i < n4; i += (size_t)gridDim.x * 512) b4[i] = (f32x4){0.f, 0.f, 0.f, 0.f};
}

typedef short bf16x4 __attribute__((ext_vector_type(4)));
__device__ __forceinline__ bf16x4 lds_tr16(const bf16_t* p) { return __builtin_amdgcn_ds_read_tr16_b64_v4i16((LAS bf16x4*)p); }
constexpr float LOG2E = 1.44269504088896341f;
#define DPP_SHR_ADD(x, n) x += __int_as_float(__builtin_amdgcn_update_dpp(0, __float_as_int(x), 0x110 + (n), 0xf, 0xf, true))
__device__ __forceinline__ float row_scan16(float x) { DPP_SHR_ADD(x, 1); DPP_SHR_ADD(x, 2); DPP_SHR_ADD(x, 4); DPP_SHR_ADD(x, 8); return x; }
__device__ __forceinline__ bf16x4 pack4(float a, float b, float c, float d) { u32x2 w; w.x = cvt_pk_bf16(a, b); w.y = cvt_pk_bf16(c, d); return __builtin_bit_cast(bf16x4, w); }
__device__ __forceinline__ bf16x8 pack8(float a0, float a1, float a2, float a3, float b0, float b1, float b2, float b3) {
    u32x4 w; w.x = cvt_pk_bf16(a0, a1); w.y = cvt_pk_bf16(a2, a3); w.z = cvt_pk_bf16(b0, b1); w.w = cvt_pk_bf16(b2, b3); return __builtin_bit_cast(bf16x8, w); }
#define WAVE_FENCE() do { asm volatile("s_waitcnt lgkmcnt(0)" ::: "memory"); __builtin_amdgcn_wave_barrier(); } while (0)

template <int BR, int PASS>
__device__ __forceinline__ void scan_wave_item(const Params& p, int l, const bf16_t* P, float* OACC, bf16_t* OB, int item, bf16_t* ldsw, bf16_t* ldsv, float* xbuf, int wave) {
    constexpr int NT = 2, NU = 1, NVT = 8;
    const int lane = otid() & 63, i = lane & 15, g = lane >> 4;
    const int sc = item & 15, cs = item >> 4;
    int ds, dir, h, bl;
    if (BR == 0) { ds = cs & 1; dir = (cs >> 1) & 1; h = (cs >> 2) & 3; bl = cs >> 4; }
    else { ds = cs & 3; dir = (cs >> 2) & 1; h = (cs >> 3) & 3; bl = cs >> 5; }
    const int d0 = ds * 32;
    const int gid = (BR ? 512 : 0) + item;
    bf16_t* SLOC = (bf16_t*)(p.ws + WS_SLOC); float* LAb = (float*)(p.ws + WS_LA);
    float cst[NT][4];
    bf16x4 upA[NT];
#pragma unroll
    for (int t = 0; t < NT; ++t) {
#pragma unroll
        for (int r = 0; r < 4; ++r) {
            const int d = 16 * t + 4 * g + r;
            cst[t][r] = BR ? ((const float*)(p.ws + WS_LB))[l * 1024 + dir * 512 + h * 128 + d0 + d] : p.in[8][(l * 2 + dir) * 256 + h * 64 + d0 + d];
        }
        if (BR == 0) {
            const float* upp = p.in[7] + ((size_t)(l * 2 + dir) * 16 + 4 * g) * 256 + h * 64 + d0 + 16 * t + i;
            upA[t] = pack4(upp[0], upp[256], upp[512], upp[768]);
        } else upA[t] = (bf16x4){0, 0, 0, 0};
    }
    f32x4 S[NT][NVT];
    float LAsum[NT][4];
#pragma unroll
    for (int t = 0; t < NT; ++t) {
#pragma unroll
        for (int r = 0; r < 4; ++r) LAsum[t][r] = 0.f;
#pragma unroll
        for (int vt = 0; vt < NVT; ++vt) S[t][vt] = (f32x4){0.f, 0.f, 0.f, 0.f};
    }
    if (PASS == 3) {
        float dec[NT][4];
#pragma unroll
        for (int t = 0; t < NT; ++t)
#pragma unroll
            for (int r = 0; r < 4; ++r) dec[t][r] = 1.f;
#pragma unroll 2
        for (int s2 = sc - 1; s2 >= 0; --s2) {
            const int g2 = gid - sc + s2;
            const float* lap = LAb + (size_t)g2 * 128 + g * 32;
            const u32x4* sp = (const u32x4*)(SLOC + (size_t)g2 * 4096) + lane;
            u32x4 w[8];
#pragma unroll
            for (int k = 0; k < 8; ++k) w[k] = sp[64 * k];
#pragma unroll
            for (int t = 0; t < NT; ++t) {
                const f32x4 la4 = *(const f32x4*)(lap + 4 * t);
#pragma unroll
                for (int vt = 0; vt < NVT; ++vt) {
                    const int idx = (t * NVT + vt) * 4, k = idx >> 3, hf = (idx >> 2) & 1;
                    const unsigned w0 = hf ? w[k].z : w[k].x, w1 = hf ? w[k].w : w[k].y;
                    S[t][vt][0] += dec[t][0] * bflo(w0); S[t][vt][1] += dec[t][1] * bfhi(w0);
                    S[t][vt][2] += dec[t][2] * bflo(w1); S[t][vt][3] += dec[t][3] * bfhi(w1);
                }
#pragma unroll
                for (int r = 0; r < 4; ++r) dec[t][r] *= __builtin_amdgcn_exp2f(la4[r]);
            }
        }
    }
    const int qc = (BR ? (C_HQ + h * 128) : (C_GQ + h * 64)) + d0, kc = (BR ? (C_HF + dir * 512 + h * 128) : (C_GK + h * 64)) + d0;
    const int vcol = (BR ? C_HI : C_GV) + h * 128 + i;
    const int ocol = BR * 512 + h * 128 + i;
    u32x2 krN[NT], qrN[NT]; u32x4 vrN[4]; bf16x4 lrBN = (bf16x4){0, 0, 0, 0};
    const int vcolb = (BR ? C_HI : C_GV) + h * 128;
#define SCAN_LOAD(n_) do { const int pos0_ = sc * 256 + (n_) * 16; const int tt_ = dir ? (T - 1 - (pos0_ + i)) : (pos0_ + i); \
        const bf16_t* prow_ = P + (size_t)(bl * 4096 + tt_) * LDP; \
        _Pragma("unroll") for (int t_ = 0; t_ < NT; ++t_) { krN[t_] = *(const u32x2*)(prow_ + kc + 16 * t_ + 4 * g); \
            if (PASS == 3) qrN[t_] = *(const u32x2*)(prow_ + qc + 16 * t_ + 4 * g); else qrN[t_] = (u32x2){0u, 0u}; } \
        if (BR == 0) lrBN = *(const bf16x4*)(prow_ + C_LR + dir * 16 + 4 * g); \
        _Pragma("unroll") for (int x_ = 0; x_ < 4; ++x_) vrN[x_] = *(const u32x4*)(prow_ + vcolb + 32 * g + 8 * x_); } while (0)
    SCAN_LOAD(0);
    for (int n = 0; n < 16; ++n) {
        const int pos0 = sc * 256 + n * 16;
        u32x2 krC[NT], qrC[NT]; bf16x4 Vb[NVT]; const bf16x4 lrB = lrBN;
#pragma unroll
        for (int t = 0; t < NT; ++t) { krC[t] = krN[t]; qrC[t] = qrN[t]; }
        {
#pragma unroll
            for (int x = 0; x < 4; ++x) *(u32x4*)(ldsv + i * 144 + 32 * g + 8 * x) = vrN[x];
            WAVE_FENCE();
            const bf16_t* tp = ldsv + (4 * g + ((lane >> 2) & 3)) * 144 + 4 * (lane & 3);
#pragma unroll
            for (int vt = 0; vt < NVT; ++vt) Vb[vt] = lds_tr16(tp + 16 * vt);
            WAVE_FENCE();
        }
        if (n + 1 < 16) SCAN_LOAD(n + 1);
        f32x4 sT = (f32x4){0.f, 0.f, 0.f, 0.f};
        f32x4 o[NVT];
#pragma unroll
        for (int vt = 0; vt < NVT; ++vt) o[vt] = (f32x4){0.f, 0.f, 0.f, 0.f};
#pragma unroll
        for (int u = 0; u < NU; ++u) {
            float kv[8], qv[8], la[8];
            u32x2 kr[2], qr[2];
#pragma unroll
            for (int x = 0; x < 2; ++x) { kr[x] = krC[2 * u + x]; qr[x] = qrC[2 * u + x]; }
#pragma unroll
            for (int x = 0; x < 2; ++x) {
                const int t = 2 * u + x;
                const float k0 = bflo(kr[x].x), k1 = bfhi(kr[x].x), k2 = bflo(kr[x].y), k3 = bfhi(kr[x].y);
                const float q0 = bflo(qr[x].x), q1 = bfhi(qr[x].x), q2 = bflo(qr[x].y), q3 = bfhi(qr[x].y);
                const float kk[4] = {k0, k1, k2, k3}, qq[4] = {q0, q1, q2, q3};
                if (BR == 0) {
                    const f32x4 z = __builtin_amdgcn_mfma_f32_16x16x16bf16_1k(upA[t], lrB, (f32x4){cst[t][0], cst[t][1], cst[t][2], cst[t][3]}, 0, 0, 0);
#pragma unroll
                    for (int r = 0; r < 4; ++r) {
                        la[4 * x + r] = (fminf(z[r], 0.f) * LOG2E - __builtin_amdgcn_logf(1.f + __builtin_amdgcn_exp2f(-fabsf(z[r]) * LOG2E))) * (1.f / 16.f);
                        kv[4 * x + r] = kk[r]; qv[4 * x + r] = qq[r] * 0.125f;
                    }
                } else {
#pragma unroll
                    for (int r = 0; r < 4; ++r) {
                        const float z = fminf(fmaxf(kk[r], -80.f), 80.f), lbv = cst[t][r];
                        const float ez = __builtin_amdgcn_exp2f(-z * LOG2E), sg = __builtin_amdgcn_rcpf(1.f + ez), sn = ez * sg;
                        la[4 * x + r] = __builtin_amdgcn_logf(fmaxf(lbv + (1.f - lbv) * sg, 1e-30f));
                        kv[4 * x + r] = (1.f - lbv) * sn;
                        qv[4 * x + r] = qq[r] * __builtin_amdgcn_rcpf(1.f + __builtin_amdgcn_exp2f(-qq[r] * LOG2E));
                    }
                }
            }
            float bb[8], bl_[8];
#pragma unroll
            for (int e = 0; e < 8; ++e) { bb[e] = row_scan16(la[e]); bl_[e] = __shfl(bb[e], (lane & 48) | 15); }
            {
                float kd[8];
#pragma unroll
                for (int e = 0; e < 8; ++e) kd[e] = kv[e] * __builtin_amdgcn_exp2f(bl_[e] - bb[e]);
#pragma unroll
                for (int x = 0; x < 2; ++x) {
                    u32x2 w2; w2.x = cvt_pk_bf16(kd[4 * x], kd[4 * x + 1]); w2.y = cvt_pk_bf16(kd[4 * x + 2], kd[4 * x + 3]);
                    *(u32x2*)(ldsw + i * 36 + 16 * (2 * u + x) + 4 * g) = w2;
                }
            }
            if (PASS == 3) {
                float qt[8], kt[8], qd[8];
#pragma unroll
                for (int e = 0; e < 8; ++e) {
                    const float bm = __shfl(bb[e], (lane & 48) | 7);
                    qt[e] = qv[e] * __builtin_amdgcn_exp2f(bb[e] - bm); kt[e] = kv[e] * __builtin_amdgcn_exp2f(bm - bb[e]); qd[e] = qv[e] * __builtin_amdgcn_exp2f(bb[e]);
                }
                const bf16x8 kt8 = pack8(kt[0], kt[1], kt[2], kt[3], kt[4], kt[5], kt[6], kt[7]);
                const bf16x8 qt8 = pack8(qt[0], qt[1], qt[2], qt[3], qt[4], qt[5], qt[6], qt[7]);
                const bf16x8 qd8 = pack8(qd[0], qd[1], qd[2], qd[3], qd[4], qd[5], qd[6], qd[7]);
                sT = __builtin_amdgcn_mfma_f32_16x16x32_bf16(kt8, qt8, sT, 0, 0, 0);
#pragma unroll
                for (int vt = 0; vt < NVT; ++vt) {
                    const f32x4 sa = S[2 * u][vt], sb = S[2 * u + 1][vt];
                    const bf16x8 sb8 = pack8(sa[0], sa[1], sa[2], sa[3], sb[0], sb[1], sb[2], sb[3]);
                    o[vt] = __builtin_amdgcn_mfma_f32_16x16x32_bf16(qd8, sb8, o[vt], 0, 0, 0);
                }
            }
            WAVE_FENCE();
#pragma unroll
            for (int x = 0; x < 2; ++x) {
                const int t = 2 * u + x;
                const bf16x4 kdT = lds_tr16(ldsw + (4 * g + ((lane >> 2) & 3)) * 36 + 16 * t + 4 * (lane & 3));
                float a[4];
#pragma unroll
                for (int r = 0; r < 4; ++r) { a[r] = __builtin_amdgcn_exp2f(bl_[4 * x + r]); if (PASS == 1) LAsum[t][r] += bl_[4 * x + r]; }
#pragma unroll
                for (int vt = 0; vt < NVT; ++vt) {
                    f32x4 c = S[t][vt];
                    c[0] *= a[0]; c[1] *= a[1]; c[2] *= a[2]; c[3] *= a[3];
                    S[t][vt] = __builtin_amdgcn_mfma_f32_16x16x16bf16_1k(kdT, Vb[vt], c, 0, 0, 0);
                }
            }
            WAVE_FENCE();
        }
        if (PASS == 3) {
            size_t vro[4];
#pragma unroll
            for (int r = 0; r < 4; ++r) { const int pp = pos0 + 4 * g + r; vro[r] = (size_t)(bl * 4096 + (dir ? (T - 1 - pp) : pp)); }
            const bf16x4 Pm = pack4((4 * g + 0 <= i) ? sT[0] : 0.f, (4 * g + 1 <= i) ? sT[1] : 0.f, (4 * g + 2 <= i) ? sT[2] : 0.f, (4 * g + 3 <= i) ? sT[3] : 0.f);
#pragma unroll
            for (int vt = 0; vt < NVT; ++vt) {
                o[vt] = __builtin_amdgcn_mfma_f32_16x16x16bf16_1k(Pm, Vb[vt], o[vt], 0, 0, 0);
            }
#pragma unroll
            for (int vt = 0; vt < NVT; ++vt)
#pragma unroll
                for (int r = 0; r < 4; ++r) xbuf[(wave * 32 + vt * 4 + r) * 64 + lane] = o[vt][r];
            __syncthreads();
            {
                constexpr int NPART = BR ? 4 : 2, NMINE = 8 / NPART;
                const int wg = wave & 3, pbase = BR ? (wave & ~3) : (wave & ~1), vt0 = (BR ? wg : (wg & 1)) * NMINE;
#pragma unroll
                for (int m = 0; m < NMINE; ++m) {
                    const int vt = vt0 + m;
#pragma unroll
                    for (int r = 0; r < 4; ++r) {
                        float s = 0.f;
#pragma unroll
                        for (int q = 0; q < NPART; ++q) s += xbuf[((pbase + q) * 32 + vt * 4 + r) * 64 + lane];
                        if (dir == 0) OACC[vro[r] * 1024 + ocol + 16 * vt] = s;
                        else OB[vro[r] * 1024 + ocol + 16 * vt] = (bf16_t)(cvt_pk_bf16(s, s) & 0xffffu);
                    }
                }
            }
            __syncthreads();
        }
    }
    if (PASS == 1) {
        u32x4* sp = (u32x4*)(SLOC + (size_t)gid * 4096) + lane;
        unsigned wv[32];
#pragma unroll
        for (int t = 0; t < NT; ++t)
#pragma unroll
            for (int vt = 0; vt < NVT; ++vt) {
                const int idx = (t * NVT + vt) * 4;
                wv[idx >> 1] = cvt_pk_bf16(S[t][vt][0], S[t][vt][1]); wv[(idx >> 1) + 1] = cvt_pk_bf16(S[t][vt][2], S[t][vt][3]);
            }
#pragma unroll
        for (int k = 0; k < 8; ++k) sp[64 * k] = (u32x4){wv[4 * k], wv[4 * k + 1], wv[4 * k + 2], wv[4 * k + 3]};
        if (i == 0) {
            float* lap = LAb + (size_t)gid * 128 + g * 32;
#pragma unroll
            for (int t = 0; t < NT; ++t) *(f32x4*)(lap + 4 * t) = (f32x4){LAsum[t][0], LAsum[t][1], LAsum[t][2], LAsum[t][3]};
        }
    }
}

__device__ __forceinline__ void na_wave_item(bf16_t* P, int item, bf16_t* ldsw, const float* rpbL) {
    const int lane = otid() & 63, i = lane & 15, g = lane >> 4;
    const int qt = item & 3, r = (item >> 2) & 63, h = (item >> 8) & 7, bl = item >> 11;
    const int rs = min(max(r - 4, 0), 56);
    const int kc0 = (qt == 0) ? 0 : (qt == 1) ? 8 : (qt == 2) ? 24 : 32;
    const int w = 16 * qt + i, cs = min(max(w - 8, 0), 48);
    const bf16_t* qp = P + (size_t)(bl * 4096 + r * 64 + w) * LDP + C_NAQ + h * 64 + 8 * g;
    const bf16x8 q0 = *(const bf16x8*)qp, q1 = *(const bf16x8*)(qp + 32);
    f32x4 sc[8][2];
#pragma unroll
    for (int kt = 0; kt < 2; ++kt) {
        bf16x8 ka[8], kb[8];
#pragma unroll
        for (int j = 0; j < 8; ++j) {
            const bf16_t* kp = P + (size_t)(bl * 4096 + (rs + j) * 64 + kc0 + 16 * kt + i) * LDP + C_NAK + h * 64 + 8 * g;
            ka[j] = *(const bf16x8*)kp; kb[j] = *(const bf16x8*)(kp + 32);
        }
#pragma unroll
        for (int j = 0; j < 8; ++j) {
            const f32x4 a = __builtin_amdgcn_mfma_f32_16x16x32_bf16(ka[j], q0, (f32x4){0.f, 0.f, 0.f, 0.f}, 0, 0, 0);
            sc[j][kt] = __builtin_amdgcn_mfma_f32_16x16x32_bf16(kb[j], q1, a, 0, 0, 0);
        }
    }
    const float* rp = rpbL + h * 465;
    float mx = -1e30f;
#pragma unroll
    for (int j = 0; j < 8; ++j)
#pragma unroll
        for (int kt = 0; kt < 2; ++kt)
#pragma unroll
            for (int rr = 0; rr < 4; ++rr) {
                const int kcol = kc0 + 16 * kt + 4 * g + rr;
                const bool valid = (kcol >= cs) && (kcol < cs + 16);
                const int coff = min(max(kcol - w + 15, 0), 30);
                float s = sc[j][kt][rr] * 0.125f + rp[(rs + j - r + 7) * 31 + coff];
                s = valid ? s : -1e30f;
                sc[j][kt][rr] = s; mx = fmaxf(mx, s);
            }
    mx = fmaxf(mx, __shfl_xor(mx, 16)); mx = fmaxf(mx, __shfl_xor(mx, 32));
    float sum = 0.f;
#pragma unroll
    for (int j = 0; j < 8; ++j)
#pragma unroll
        for (int kt = 0; kt < 2; ++kt)
#pragma unroll
            for (int rr = 0; rr < 4; ++rr) { const float e = __expf(sc[j][kt][rr] - mx); sc[j][kt][rr] = e; sum += e; }
    sum += __shfl_xor(sum, 16); sum += __shfl_xor(sum, 32);
    const float inv = 1.f / sum;
    f32x4 oT[4];
#pragma unroll
    for (int dt = 0; dt < 4; ++dt) oT[dt] = (f32x4){0.f, 0.f, 0.f, 0.f};
    const int vkey = lane & 31, vdh = lane >> 5;
    const bf16_t* vp0 = P + (size_t)(bl * 4096 + rs * 64 + kc0 + vkey) * LDP + C_NAV + h * 64 + vdh * 32;
    u32x4 vn[4];
#pragma unroll
    for (int x = 0; x < 4; ++x) vn[x] = ((const u32x4*)vp0)[x];
#pragma unroll
    for (int j = 0; j < 8; ++j) {
        u32x4 v[4];
#pragma unroll
        for (int x = 0; x < 4; ++x) v[x] = vn[x];
        if (j + 1 < 8) {
#pragma unroll
            for (int x = 0; x < 4; ++x) vn[x] = ((const u32x4*)(vp0 + (size_t)(j + 1) * 64 * LDP))[x];
        }
#pragma unroll
        for (int x = 0; x < 4; ++x) *(u32x4*)(ldsw + vkey * 72 + vdh * 32 + 8 * x) = v[x];
        WAVE_FENCE();
        const bf16x8 p8 = pack8(sc[j][0][0], sc[j][0][1], sc[j][0][2], sc[j][0][3], sc[j][1][0], sc[j][1][1], sc[j][1][2], sc[j][1][3]);
#pragma unroll
        for (int dt = 0; dt < 4; ++dt) {
            const bf16x4 va = lds_tr16(ldsw + (4 * g + ((lane >> 2) & 3)) * 72 + 16 * dt + 4 * (lane & 3)), vb = lds_tr16(ldsw + (16 + 4 * g + ((lane >> 2) & 3)) * 72 + 16 * dt + 4 * (lane & 3));
            const bf16x8 a8 = (bf16x8){va[0], va[1], va[2], va[3], vb[0], vb[1], vb[2], vb[3]};
            oT[dt] = __builtin_amdgcn_mfma_f32_16x16x32_bf16(a8, p8, oT[dt], 0, 0, 0);
        }
        WAVE_FENCE();
    }
    bf16_t* op = P + (size_t)(bl * 4096 + r * 64 + w) * LDP + C_NAQ + h * 64 + 4 * g;
#pragma unroll
    for (int dt = 0; dt < 4; ++dt) {
        u32x2 o2; o2.x = cvt_pk_bf16(oT[dt][0] * inv, oT[dt][1] * inv); o2.y = cvt_pk_bf16(oT[dt][2] * inv, oT[dt][3] * inv);
        *(u32x2*)(op + 16 * dt) = o2;
    }
}

__device__ __forceinline__ void normgate_block(const Params& p, int l, bf16_t* P, const float* OACC, const bf16_t* OB, int tok0, int br, int h0, int nh);
__device__ __forceinline__ void na_phase_body(const Params& p, int l, int half, bf16_t* P, unsigned char* smem) {
    const int tid = otid(), wave = __builtin_amdgcn_readfirstlane(tid >> 6), lane = tid & 63;
    float* rpbL = (float*)(smem + 32768);
    for (int idx = tid; idx < 8 * 465; idx += 512) rpbL[idx] = p.in[6][(size_t)l * 8 * 465 + idx];
    __syncthreads();
    unsigned* ctr = (unsigned*)(p.ws + WS_CTL) + (l * 2 + half) * 16;
    bf16_t* ldsw = (bf16_t*)(smem + 49152 + wave * 4608);
    for (;;) {
        int it = 0;
        if (lane == 0) it = (int)atomicAdd(ctr, 1u);
        it = __builtin_amdgcn_readfirstlane(it);
        if (it >= 1024) break;
        for (int q4 = 0; q4 < 4; ++q4) na_wave_item(P, it * 4 + q4, ldsw, rpbL);
    }
}
__device__ __forceinline__ void phase_scan3(const Params& p, int l, int half, const bf16_t* P, bf16_t* Pw, float* OACC, bf16_t* OB, unsigned char* smem) {
    const int wave = __builtin_amdgcn_readfirstlane(otid() >> 6), wg = wave & 3;
    bf16_t* ldsw = (bf16_t*)(smem + wave * 4096);
    bf16_t* ldsv = (bf16_t*)(smem + 98304 + wave * 4608);
    float* xbuf = (float*)(smem + 32768);
    if (gridDim.x > 192 && blockIdx.x >= 192) {
        na_phase_body(p, l, half, Pw, smem);
        return;
    }
    for (int b = blockIdx.x; b < 192; b += gridDim.x) {
        const int dir = wave >> 2;
        if (b < 128) {
            const int sc0 = b & 15, h = (b >> 4) & 3, bl = b >> 6, sc = dir ? 15 - sc0 : sc0;
            const int cs = wg | (dir << 2) | (h << 3) | (bl << 5);
            scan_wave_item<1, 3>(p, l, P, OACC, OB, cs * 16 + sc, ldsw, ldsv, xbuf, wave);
            asm volatile("s_waitcnt vmcnt(0)" ::: "memory");
            __syncthreads();
            normgate_block(p, l, Pw, OACC, OB, bl * 4096 + sc0 * 256, 1, h, 1);
        } else {
            const int q = b - 128, sc0 = q & 15, hp = (q >> 4) & 1, bl = q >> 5, sc = dir ? 15 - sc0 : sc0;
            const int h = hp * 2 + (wg >> 1), ds = wg & 1;
            const int cs = ds | (dir << 1) | (h << 2) | (bl << 4);
            scan_wave_item<0, 3>(p, l, P, OACC, OB, cs * 16 + sc, ldsw, ldsv, xbuf, wave);
            asm volatile("s_waitcnt vmcnt(0)" ::: "memory");
            __syncthreads();
            normgate_block(p, l, Pw, OACC, OB, bl * 4096 + sc0 * 256, 0, hp * 2, 2);
        }
        __syncthreads();
    }
}

__device__ __forceinline__ void phase_mix1(const Params& p, int l, int half, bf16_t* P, float* OACC, bf16_t* OB, unsigned char* smem) {
    const int wave = __builtin_amdgcn_readfirstlane(otid() >> 6);
    bf16_t* ldsw = (bf16_t*)(smem + wave * 4096);
    bf16_t* ldsv = (bf16_t*)(smem + 98304 + wave * 4608);
    const int wg = wave & 3;
    for (int b = blockIdx.x; b < 192; b += gridDim.x) {
        const int G = b * 2 + (wave >> 2);
        if (b < 128) {
            const int sc = G & 15, rest = G >> 4, dir = rest & 1, h = (rest >> 1) & 3, bl = rest >> 3;
            const int cs = wg | (dir << 2) | (h << 3) | (bl << 5);
            scan_wave_item<1, 1>(p, l, P, OACC, OB, cs * 16 + sc, ldsw, ldsv, nullptr, 0);
        } else {
            const int G2 = G - 256, sc = G2 & 15, rest = G2 >> 4, dir = rest & 1, hp = (rest >> 1) & 1, bl = rest >> 2;
            const int h = hp * 2 + (wg >> 1), ds = wg & 1;
            const int cs = ds | (dir << 1) | (h << 2) | (bl << 4);
            scan_wave_item<0, 1>(p, l, P, OACC, OB, cs * 16 + sc, ldsw, ldsv, nullptr, 0);
        }
    }
    if (gridDim.x <= 192) { __syncthreads(); na_phase_body(p, l, half, P, smem); }
}

__device__ __forceinline__ float silu_fast(float x) { return x * __builtin_amdgcn_rcpf(1.f + __expf(-x)); }
__device__ __forceinline__ void normgate_block(const Params& p, int l, bf16_t* P, const float* OACC, const bf16_t* OB, int tok0, int br, int h0, int nh) {
    const int tid = otid(), sub = tid & 15, rowi = tid >> 4;
    const float* nw = (br ? p.in[11] : p.in[9]) + l * 128 + sub * 8;
    const f32x4 w0 = *(const f32x4*)nw, w1 = *(const f32x4*)(nw + 4);
    for (int rr = rowi; rr < 256 * nh; rr += 32) {
        const int tok = tok0 + (rr / nh), h = h0 + (rr % nh);
        const size_t oo = (size_t)tok * 1024 + br * 512 + h * 128 + sub * 8;
        f32x4 a0 = *(const f32x4*)(OACC + oo), a1 = *(const f32x4*)(OACC + oo + 4);
        const u32x4 b = *(const u32x4*)(OB + oo);
        bf16_t* gp = P + (size_t)tok * LDP + (br ? C_HG : C_GG) + h * 128 + sub * 8;
        const u32x4 g = *(const u32x4*)gp;
        a0[0] += bflo(b.x); a0[1] += bfhi(b.x); a0[2] += bflo(b.y); a0[3] += bfhi(b.y); a1[0] += bflo(b.z); a1[1] += bfhi(b.z); a1[2] += bflo(b.w); a1[3] += bfhi(b.w);
        float ss = (a0[0] * a0[0] + a0[1] * a0[1]) + (a0[2] * a0[2] + a0[3] * a0[3]) + (a1[0] * a1[0] + a1[1] * a1[1]) + (a1[2] * a1[2] + a1[3] * a1[3]);
        ss += __shfl_xor(ss, 1); ss += __shfl_xor(ss, 2); ss += __shfl_xor(ss, 4); ss += __shfl_xor(ss, 8);
        const float rstd = rsqrtf(ss * (1.f / 128.f) + 1e-6f);
        u32x4 w;
        w.x = cvt_pk_bf16(a0[0] * rstd * w0[0] * silu_fast(bflo(g.x)), a0[1] * rstd * w0[1] * silu_fast(bfhi(g.x)));
        w.y = cvt_pk_bf16(a0[2] * rstd * w0[2] * silu_fast(bflo(g.y)), a0[3] * rstd * w0[3] * silu_fast(bfhi(g.y)));
        w.z = cvt_pk_bf16(a1[0] * rstd * w1[0] * silu_fast(bflo(g.z)), a1[1] * rstd * w1[1] * silu_fast(bfhi(g.z)));
        w.w = cvt_pk_bf16(a1[2] * rstd * w1[2] * silu_fast(bflo(g.w)), a1[3] * rstd * w1[3] * silu_fast(bfhi(g.w)));
        *(u32x4*)gp = w;
    }
}
__device__ __forceinline__ void phase_normgate(const Params& p, int l, bf16_t* P, const float* OACC, const bf16_t* OB) {
    const int tid_ = otid(); const int lane = tid_ & 63, gw = blockIdx.x * 8 + (tid_ >> 6), ngw = gridDim.x * 8;
    for (int ib = gw * 4; ib < MH * 2; ib += ngw * 4) {
        f32x4 o0[4], o1[4]; u32x4 ob[4], gq[4];
#pragma unroll
        for (int q = 0; q < 4; ++q) {
            const int it = ib + q, tok = it >> 1, br = it & 1;
            const float* op = OACC + (size_t)tok * 1024 + br * 512 + lane * 8;
            o0[q] = *(const f32x4*)op; o1[q] = *(const f32x4*)(op + 4);
            ob[q] = *(const u32x4*)(OB + (size_t)tok * 1024 + br * 512 + lane * 8);
            gq[q] = *(const u32x4*)(P + (size_t)tok * LDP + (br ? C_HG : C_GG) + lane * 8);
        }
#pragma unroll
        for (int q = 0; q < 4; ++q) {
            const int it = ib + q, tok = it >> 1, br = it & 1;
            f32x4 a0 = o0[q], a1 = o1[q]; const u32x4 b = ob[q], g = gq[q];
            a0[0] += bflo(b.x); a0[1] += bfhi(b.x); a0[2] += bflo(b.y); a0[3] += bfhi(b.y); a1[0] += bflo(b.z); a1[1] += bfhi(b.z); a1[2] += bflo(b.w); a1[3] += bfhi(b.w);
            float ss = (a0[0] * a0[0] + a0[1] * a0[1]) + (a0[2] * a0[2] + a0[3] * a0[3]) + (a1[0] * a1[0] + a1[1] * a1[1]) + (a1[2] * a1[2] + a1[3] * a1[3]);
            ss += __shfl_xor(ss, 1); ss += __shfl_xor(ss, 2); ss += __shfl_xor(ss, 4); ss += __shfl_xor(ss, 8);
            const float rstd = rsqrtf(ss * (1.f / 128.f) + 1e-6f);
            const float* nw = (br ? p.in[11] : p.in[9]) + l * 128 + (lane & 15) * 8;
            const f32x4 w0 = *(const f32x4*)nw, w1 = *(const f32x4*)(nw + 4);
            u32x4 w;
            w.x = cvt_pk_bf16(a0[0] * rstd * w0[0] * silu_fast(bflo(g.x)), a0[1] * rstd * w0[1] * silu_fast(bfhi(g.x)));
            w.y = cvt_pk_bf16(a0[2] * rstd * w0[2] * silu_fast(bflo(g.y)), a0[3] * rstd * w0[3] * silu_fast(bfhi(g.y)));
            w.z = cvt_pk_bf16(a1[0] * rstd * w1[0] * silu_fast(bflo(g.z)), a1[1] * rstd * w1[1] * silu_fast(bfhi(g.z)));
            w.w = cvt_pk_bf16(a1[2] * rstd * w1[2] * silu_fast(bflo(g.w)), a1[3] * rstd * w1[3] * silu_fast(bfhi(g.w)));
            *(u32x4*)(P + (size_t)tok * LDP + (br ? C_HG : C_GG) + lane * 8) = w;
        }
    }
}

#define XB_TMO      128
#define XB_XCNT(j)  (256  + 64 * (j))
#define XB_XSUB(j)  (1280 + 64 * (j))
#define XB_XGEN(j)  (2304 + 64 * (j))
#define XB_TOP      3328
#define XB_TOPGEN   3392
#define XCD_BAR_WORDS 3456
#define XB_SPIN_CAP (1u << 18)

__device__ __forceinline__ unsigned xb_ld(unsigned* p)              { return __hip_atomic_load(p, __ATOMIC_RELAXED, __HIP_MEMORY_SCOPE_AGENT); }
__device__ __forceinline__ unsigned xb_add(unsigned* p, unsigned v) { return __hip_atomic_fetch_add(p, v, __ATOMIC_RELAXED, __HIP_MEMORY_SCOPE_AGENT); }
__device__ __forceinline__ unsigned xb_xcc_id() { return (unsigned)__builtin_amdgcn_s_getreg((3 << 11) | 20) & 0xFu; }
#define XB_SPIN(cond, bar) do { unsigned _sp = 0; while (cond) { __builtin_amdgcn_s_sleep(1); \
    if ((++_sp & 255u) == 0u) { if (xb_ld(&(bar)[XB_TMO])) break; if (_sp > XB_SPIN_CAP) { atomicAdd(&(bar)[XB_TMO], 1u); break; } } } } while (0)

struct XcdBarrier {
    unsigned* bar; unsigned x;
    volatile LAS unsigned* st;
};

__device__ __forceinline__ XcdBarrier xcd_barrier_post(unsigned* bar, volatile LAS unsigned* st) {
    XcdBarrier b; b.bar = bar; b.x = xb_xcc_id(); b.st = st;
    if (threadIdx.x == 0) (void)xb_add(&bar[XB_XCNT(b.x)], 1u);
    return b;
}
__device__ __forceinline__ void xcd_barrier_complete(unsigned* bar, unsigned x, unsigned& nloc, unsigned& nx) {
    const unsigned G = gridDim.x * gridDim.y * gridDim.z;
    unsigned sum, cnt, mine, sp = 0u;
    for (;;) {
        sum = 0u; cnt = 0u; mine = 0u;
#pragma unroll
        for (unsigned j = 0; j < 16; ++j) { const unsigned c = xb_ld(&bar[XB_XCNT(j)]); sum += c; cnt += (c > 0u) ? 1u : 0u; mine = (j == x) ? c : mine; }
        if (sum == G) break;
        __builtin_amdgcn_s_sleep(1);
        if ((++sp & 255u) == 0u) { if (xb_ld(&bar[XB_TMO])) break; if (sp > XB_SPIN_CAP) { atomicAdd(&bar[XB_TMO], 1u); break; } }
    }
    nloc = mine > 0u ? mine : 1u; nx = cnt > 0u ? cnt : 1u;
}

__device__ __forceinline__ void xcd_barrier(const XcdBarrier& b) {
    asm volatile("s_waitcnt vmcnt(0)" ::: "memory");
    __syncthreads();
    if (threadIdx.x == 0) {
        unsigned* bar = b.bar;
        __builtin_amdgcn_s_waitcnt(0);
        unsigned nloc = b.st[0], nx = b.st[1];
        if (nloc == 0u) { xcd_barrier_complete(bar, b.x, nloc, nx); b.st[0] = nloc; b.st[1] = nx; }
        const unsigned old = xb_add(&bar[XB_XSUB(b.x)], 1u);
        const unsigned gen = old / nloc;
        if (old + 1u == (gen + 1u) * nloc) {
            __builtin_amdgcn_fence(__ATOMIC_RELEASE, "agent");
            asm volatile("s_waitcnt vmcnt(0)" ::: "memory");
            const unsigned og = xb_add(&bar[XB_TOP], 1u);
            const unsigned tg = og / nx;
            if (og + 1u == (tg + 1u) * nx) xb_add(&bar[XB_TOPGEN], 1u);
            else XB_SPIN(xb_ld(&bar[XB_TOPGEN]) == tg, bar);
            __builtin_amdgcn_fence(__ATOMIC_ACQUIRE, "agent");
            xb_add(&bar[XB_XGEN(b.x)], 1u);
            asm volatile("s_waitcnt vmcnt(0)" ::: "memory");
        } else {
            XB_SPIN(xb_ld(&bar[XB_XGEN(b.x)]) == gen, bar);
            __builtin_amdgcn_fence(__ATOMIC_ACQUIRE, "agent");
            asm volatile("s_waitcnt vmcnt(0)" ::: "memory");
        }
    }
    __syncthreads();
}


#define LIB_GRID_SYNC() do { asm volatile("s_waitcnt vmcnt(0) lgkmcnt(0)" ::: "memory"); grid.sync(); \
        asm volatile("buffer_inv sc1\n\ts_waitcnt vmcnt(0)" ::: "memory"); } while (0)
#define GRID_SYNC() xcd_barrier(xb)
__global__ void __launch_bounds__(512, 2) fwd_megakernel(Params p) {
    extern __shared__ __attribute__((aligned(16))) unsigned char smem[];
    cg::grid_group grid = cg::this_grid();
    unsigned char* ws = p.ws;
    const float* mod = (const float*)(ws + WS_MOD);
    bf16_t* Wt_in = (bf16_t*)(ws + WS_WIN); bf16_t* Wt_proj = (bf16_t*)(ws + WS_WPROJ); bf16_t* Wt_out = (bf16_t*)(ws + WS_WOUT);
    bf16_t* Wt_gu = (bf16_t*)(ws + WS_WGU); bf16_t* Wt_dn = (bf16_t*)(ws + WS_WDN);
    bf16_t* H = (bf16_t*)(ws + WS_H); bf16_t* MG = (bf16_t*)(ws + WS_MERGED); float* OACC = (float*)(ws + WS_OACC);
    bf16_t* P = (bf16_t*)(ws + WS_P); bf16_t* GT = (bf16_t*)(ws + WS_GT); bf16_t* H2 = (bf16_t*)(ws + WS_H2); bf16_t* HID = (bf16_t*)(ws + WS_HID);

    volatile LAS unsigned* xb_st = (volatile LAS unsigned*)(smem + 135168 + 64);
    if (otid() == 0) { xb_st[0] = 0u; xb_st[1] = 0u; xb_st[2] = 0u; xb_st[3] = 0u; }
    __syncthreads();
    const XcdBarrier xb = xcd_barrier_post((unsigned*)(ws + WS_BAR), xb_st);
    phase_prep(p, smem);
    __syncthreads();
    phase_convert(p, 0, smem);
    GRID_SYNC();
    for (int l = 0; l < DEPTH; ++l) {
        bf16_t* XB = (bf16_t*)p.out;
        const float* modl = mod + (size_t)l * 4 * 6144;
        if (l) phase_convert(p, l, smem);
        for (int half = 0; half < 2; ++half) {
            if (half == 0) {
                if (l == 0) phase_modnorm<true>(p.in[0], H, 0, MH, p.in[4] + l * 1024, modl + 0, modl + 1024);
                else phase_modnorm<false>(XB, H, 0, MH, p.in[4] + l * 1024, modl + 0, modl + 1024);
                GRID_SYNC();
            }
            run_gemm(smem, H, 1024, Wt_in, MH, NPAD, 1024, EpiP{P, GT});
            if (l == 0 && half == 0) LIB_GRID_SYNC(); else GRID_SYNC();
            phase_mix1(p, l, half, P, OACC, H, smem);
            if (half == 1) phase_combine((bf16_t*)OACC + (size_t)MH * 1024, (bf16_t*)OACC, MG, gridDim.x > 192 ? 192 : 0, gridDim.x > 192 ? (int)gridDim.x - 192 : (int)gridDim.x);
            GRID_SYNC();
            phase_scan3(p, l, half, P, P, OACC, H, smem);
            GRID_SYNC();
            bf16_t* PTa = (bf16_t*)OACC + (size_t)MH * 1024; bf16_t* PTb = (bf16_t*)OACC;
            {
                pg8::Gemm g{P + C_NAQ, LDP, Wt_proj, MH, 1024, 512, (size_t)2560 * 2, (size_t)1024 * 512 * 2};
                pg8::SplitOrder S; S.init2(MH, 1024, (int)gridDim.x, (int)blockIdx.x);
                pg8::gemm_phase<EpiMerge, pg8::SplitOrder>((LAS unsigned char*)smem, g, S, EpiMerge{GT, PTa, half ? H : PTb});
            }
            if (half == 0) { if (l == 0) phase_modnorm<true>(p.in[0], H, MH, MH, p.in[4] + l * 1024, modl + 0, modl + 1024, (int)gridDim.x / 2, (int)gridDim.x - (int)gridDim.x / 2);
                             else phase_modnorm<false>(XB, H, MH, MH, p.in[4] + l * 1024, modl + 0, modl + 1024, (int)gridDim.x / 2, (int)gridDim.x - (int)gridDim.x / 2); }
            GRID_SYNC();
        }
        phase_combine((bf16_t*)OACC + (size_t)MH * 1024, H, MG + (size_t)MH * 1024, 0, (int)gridDim.x);
        GRID_SYNC();
        if (l == 0) run_gemm(smem, MG, 1024, Wt_out, M, 1024, 1024, EpiResid<true>{p.in[0], XB, modl + 2048});
        else run_gemm(smem, MG, 1024, Wt_out, M, 1024, 1024, EpiResid<false>{XB, XB, modl + 2048});
        GRID_SYNC();
        phase_modnorm<false>(XB, H2, 0, M, p.in[16] + l * 1024, modl + 3072, modl + 4096);
        GRID_SYNC();
        run_gemm(smem, H2, 1024, Wt_gu, M, 2 * FF, 1024, EpiGU{HID});
        GRID_SYNC();
        run_gemm(smem, HID, FF, Wt_dn, M, 1024, FF, EpiResid<false>{XB, l + 1 < DEPTH ? XB : H2, modl + 5120});
        GRID_SYNC();
    }
    phase_finalnorm(H2, p.out, p.in[20]);
}

extern "C" void kernel_launch(void* const* d_in, const int* in_sizes, int n_in, void* d_out, int out_size, void* d_ws, size_t ws_size, hipStream_t stream) {
    static int grid_blocks = 0;
    if (grid_blocks == 0) {
        if (n_in != 21 || ws_size < WS_END2) { fprintf(stderr, "kernel_launch: unexpected n_in %d / ws_size %zu (need %zu)\n", n_in, ws_size, (size_t)WS_END2); grid_blocks = -1; return; }
        int dev = 0, cus = 0, per_cu = 0;
        hipGetDevice(&dev);
        hipDeviceGetAttribute(&cus, hipDeviceAttributeMultiprocessorCount, dev);
        if (hipFuncSetAttribute((const void*)fwd_megakernel, hipFuncAttributeMaxDynamicSharedMemorySize, LDS_BYTES) != hipSuccess) fprintf(stderr, "kernel_launch: hipFuncSetAttribute failed\n");
        if (hipOccupancyMaxActiveBlocksPerMultiprocessor(&per_cu, (const void*)fwd_megakernel, 512, LDS_BYTES) != hipSuccess || per_cu < 1) { fprintf(stderr, "kernel_launch: occupancy query says %d\n", per_cu); per_cu = 1; }
        (void)hipGetLastError();
        if (cus <= 0) cus = 256;
        grid_blocks = cus;
    }
    if (grid_blocks < 0) return;
    (void)hipMemsetAsync((char*)d_ws + WS_CTL, 0, 32768, stream);
    Params prm{};
    for (int i = 0; i < 21; ++i) prm.in[i] = (const float*)d_in[i];
    prm.out = (float*)d_out; prm.ws = (unsigned char*)d_ws;
    void* args[] = {&prm};
    hipError_t e = hipLaunchCooperativeKernel((const void*)fwd_megakernel, dim3(grid_blocks), dim3(512), args, LDS_BYTES, stream);
    if (e != hipSuccess) fprintf(stderr, "cooperative launch failed: %s (grid %d)\n", hipGetErrorString(e), grid_blocks);
}
```
